# Optimizing an MI355X kernel written in HIP

```python
import jax, jax.numpy as jnp
from jax import lax
import numpy as np

D_MODEL = 1024
BATCH = 32
SEQ = 256
DEPTH = 2
DEC_BATCH = 2
DEC_SEQ = 4096
PAST_LEN = 256

GRID_W = 64
N_MIXERS = 2
HGRN_EXPAND = 128
HGRN_HEADS = D_MODEL // HGRN_EXPAND
HGRN_DK = HGRN_EXPAND
HGRN_DV = D_MODEL // HGRN_HEADS
CHUNK = 32
N_HGRN = (DEPTH + N_MIXERS - 1) // N_MIXERS
N_CONV = DEPTH // N_MIXERS
CONV_W = 3
D_FF = 2816
N_MOD = 6
EPS = 1e-6

kernel_name = "hybrid_hgrn2_shortconv_dit_step"


def rms_norm(x, w):
    xf = x.astype(jnp.float32)
    y = xf * lax.rsqrt(jnp.mean(xf * xf, axis=-1, keepdims=True) + EPS)
    return (y * w.astype(jnp.float32)).astype(x.dtype)


def modulate(x, w, shift, scale):
    return rms_norm(x, w) * (1.0 + scale) + shift


def dwconv3(u, w, b, axis):
    n = u.shape[axis]
    pad = [(0, 0)] * u.ndim
    pad[axis] = (1, 1)
    up = jnp.pad(u, pad)
    prev = lax.slice_in_dim(up, 0, n, axis=axis)
    nxt = lax.slice_in_dim(up, 2, n + 2, axis=axis)
    return prev * w[0] + u * w[1] + nxt * w[2] + b


def token_conv(u, w, b, grid_axis):
    if grid_axis is None:
        return dwconv3(u, w, b, axis=1)
    bsz, n, ch = u.shape
    rows = n // GRID_W
    ug = u.reshape(bsz, rows, GRID_W, ch)
    return dwconv3(ug, w, b, axis=grid_axis).reshape(bsz, n, ch)


def gla_chunk(q, k, v, log_f, s0):
    bsz, nh, n, dk = q.shape
    dv = v.shape[-1]
    nc = n // CHUNK
    q, k, log_f = (t.reshape(bsz, nh, nc, CHUNK, dk) for t in (q, k, log_f))
    v = v.reshape(bsz, nh, nc, CHUNK, dv)
    g_cum = jnp.cumsum(log_f, axis=3)
    g_last = g_cum[:, :, :, -1:, :]
    q_dec = q * jnp.exp(g_cum)
    k_intra = k * jnp.exp(-g_cum)
    k_state = k * jnp.exp(g_last - g_cum)
    lower = jnp.tril(jnp.ones((CHUNK, CHUNK), dtype=bool))
    scores = jnp.einsum("bhncd,bhnsd->bhncs", q_dec, k_intra)
    scores = jnp.where(lower, scores, 0.0)
    o_intra = jnp.einsum("bhncs,bhnse->bhnce", scores, v)
    chunk_kv = jnp.einsum("bhnsd,bhnse->nbhde", k_state, v)
    chunk_decay = jnp.moveaxis(jnp.exp(g_last[:, :, :, 0, :]), 2, 0)

    def step(s, inp):
        d, kv = inp
        return d[..., None] * s + kv, s

    s_final, s_prev = lax.scan(step, s0, (chunk_decay, chunk_kv))
    o_inter = jnp.einsum("bhncd,nbhde->bhnce", q_dec, s_prev)
    o = (o_intra + o_inter).reshape(bsz, nh, n, dv)
    return o, s_final


def hgrn2_mixer(h, w_in, lb_fwd, lb_bwd, gnorm_w, w_out, s0_fwd, s0_bwd):
    bsz, n, _ = h.shape
    hk = HGRN_HEADS * HGRN_DK
    hv = HGRN_HEADS * HGRN_DV
    proj = h @ w_in
    q, f_fwd, f_bwd, v, g = jnp.split(proj, [hk, 2 * hk, 3 * hk, 3 * hk + hv], axis=-1)

    def heads(t, d):
        return t.reshape(bsz, n, HGRN_HEADS, d).transpose(0, 2, 1, 3).astype(jnp.float32)

    qh = jax.nn.silu(heads(q, HGRN_DK))
    vh = heads(v, HGRN_DV)

    def gates(f_logit, lb):
        lb = lb.reshape(HGRN_HEADS, 1, HGRN_DK)
        f = lb + (1.0 - lb) * jax.nn.sigmoid(heads(f_logit, HGRN_DK))
        return 1.0 - f, jnp.log(f)

    k_f, lf_f = gates(f_fwd, lb_fwd)
    k_b, lf_b = gates(f_bwd, lb_bwd)
    o_f, s_f = gla_chunk(qh, k_f, vh, lf_f, s0_fwd.astype(jnp.float32))
    rev = lambda t: jnp.flip(t, axis=2)
    o_b, s_b = gla_chunk(rev(qh), rev(k_b), rev(vh), rev(lf_b), s0_bwd.astype(jnp.float32))
    o = o_f + rev(o_b)
    o = rms_norm(o, gnorm_w) * jax.nn.silu(heads(g, HGRN_DV))
    o = o.transpose(0, 2, 1, 3).reshape(bsz, n, hv).astype(h.dtype)
    return o @ w_out, s_f, s_b


def short_conv_mixer(h, w_in, conv_w, conv_b, w_out, grid_axis):
    gate_b, gate_c, u = jnp.split(h @ w_in, 3, axis=-1)
    z = token_conv(gate_c * u, conv_w, conv_b, grid_axis)
    return (gate_b * z) @ w_out


def conv_ffn(h, w_up, conv_w, conv_b, w_down, grid_axis):
    a, g = jnp.split(h @ w_up, 2, axis=-1)
    a = token_conv(a, conv_w, conv_b, grid_axis)
    return (jax.nn.silu(a) * g) @ w_down


def setup_inputs(seed: int = 0) -> dict:
    key = jax.random.key(seed)
    ks = jax.random.split(key, 22)
    hk = HGRN_HEADS * HGRN_DK
    hv = HGRN_HEADS * HGRN_DV

    def nrm(k, shape, scale):
        return jax.random.normal(k, shape, jnp.float32) * scale

    return {
        "x_prompt": nrm(ks[0], (BATCH, SEQ, D_MODEL), 1.0),
        "x_sample": nrm(ks[1], (DEC_BATCH, DEC_SEQ, D_MODEL), 1.0),
        "state_hgrn": nrm(ks[2], (DEC_BATCH, N_HGRN, 2, HGRN_HEADS, HGRN_DK, HGRN_DV), 0.5),
        "c": nrm(ks[3], (DEC_BATCH, D_MODEL), 1.0),
        "c_ctx": nrm(ks[4], (D_MODEL,), 1.0),
        "ada_w": nrm(ks[5], (DEPTH, D_MODEL, N_MOD * D_MODEL), 0.5 * D_MODEL ** -0.5),
        "ada_b": nrm(ks[6], (DEPTH, N_MOD * D_MODEL), 0.02),
        "norm_mix_w": 1.0 + nrm(ks[7], (DEPTH, D_MODEL), 0.05),
        "norm_ffn_w": 1.0 + nrm(ks[8], (DEPTH, D_MODEL), 0.05),
        "hgrn_w_in": nrm(ks[9], (N_HGRN, D_MODEL, 3 * hk + 2 * hv), D_MODEL ** -0.5),
        "hgrn_lower_bounds": nrm(ks[10], (2, N_HGRN + 1, hk), 0.1),
        "hgrn_gnorm_w": 1.0 + nrm(ks[11], (N_HGRN, HGRN_DV), 0.05),
        "hgrn_w_out": nrm(ks[12], (N_HGRN, hv, D_MODEL), hv ** -0.5),
        "sconv_w_in": nrm(ks[13], (N_CONV, D_MODEL, 3 * D_MODEL), D_MODEL ** -0.5),
        "sconv_conv_w": nrm(ks[14], (N_CONV, CONV_W, D_MODEL), CONV_W ** -0.5),
        "sconv_conv_b": nrm(ks[15], (N_CONV, D_MODEL), 0.01),
        "sconv_w_out": nrm(ks[16], (N_CONV, D_MODEL, D_MODEL), D_MODEL ** -0.5),
        "ffn_w_up": nrm(ks[17], (DEPTH, D_MODEL, 2 * D_FF), D_MODEL ** -0.5),
        "ffn_conv_w": nrm(ks[18], (DEPTH, CONV_W, D_FF), CONV_W ** -0.5),
        "ffn_conv_b": nrm(ks[19], (DEPTH, D_FF), 0.01),
        "ffn_w_down": nrm(ks[20], (DEPTH, D_FF, D_MODEL), D_FF ** -0.5),
        "final_norm_w": 1.0 + nrm(ks[21], (D_MODEL,), 0.05),
    }


def reference(x_prompt, x_sample, state_hgrn, c, c_ctx, ada_w, ada_b, norm_mix_w, norm_ffn_w,
              hgrn_w_in, hgrn_lower_bounds, hgrn_gnorm_w, hgrn_w_out,
              sconv_w_in, sconv_conv_w, sconv_conv_b, sconv_w_out,
              ffn_w_up, ffn_conv_w, ffn_conv_b, ffn_w_down, final_norm_w):
    lb_all = jnp.cumsum(jax.nn.softmax(hgrn_lower_bounds.astype(jnp.float32), axis=1), axis=1)
    zeros_state = jnp.zeros((x_prompt.shape[0], HGRN_HEADS, HGRN_DK, HGRN_DV), jnp.float32)
    xp, xs = x_prompt, x_sample
    ctx_states = []
    for l in range(DEPTH):
        mod_p = jnp.split((jax.nn.silu(c_ctx) @ ada_w[l] + ada_b[l])[None, None, :], N_MOD, axis=-1)
        mod_s = jnp.split((jax.nn.silu(c) @ ada_w[l] + ada_b[l])[:, None, :], N_MOD, axis=-1)
        hp = modulate(xp, norm_mix_w[l], mod_p[0], mod_p[1])
        hs = modulate(xs, norm_mix_w[l], mod_s[0], mod_s[1])
        j = l // N_MIXERS
        if l % N_MIXERS == 0:
            yp, sp_f, sp_b = hgrn2_mixer(hp, hgrn_w_in[j], lb_all[0, j], lb_all[1, j],
                                         hgrn_gnorm_w[j], hgrn_w_out[j], zeros_state, zeros_state)
            ctx_states.append(jnp.stack([sp_f, sp_b], axis=1))
            ys, _, _ = hgrn2_mixer(hs, hgrn_w_in[j], lb_all[0, j], lb_all[1, j],
                                   hgrn_gnorm_w[j], hgrn_w_out[j],
                                   state_hgrn[:, j, 0], state_hgrn[:, j, 1])
        else:
            yp = short_conv_mixer(hp, sconv_w_in[j], sconv_conv_w[j], sconv_conv_b[j],
                                  sconv_w_out[j], None)
            ys = short_conv_mixer(hs, sconv_w_in[j], sconv_conv_w[j], sconv_conv_b[j],
                                  sconv_w_out[j], 1)
        xp = xp + mod_p[2] * yp
        xs = xs + mod_s[2] * ys
        hp = modulate(xp, norm_ffn_w[l], mod_p[3], mod_p[4])
        hs = modulate(xs, norm_ffn_w[l], mod_s[3], mod_s[4])
        xp = xp + mod_p[5] * conv_ffn(hp, ffn_w_up[l], ffn_conv_w[l], ffn_conv_b[l], ffn_w_down[l], None)
        xs = xs + mod_s[5] * conv_ffn(hs, ffn_w_up[l], ffn_conv_w[l], ffn_conv_b[l], ffn_w_down[l], 2)
    y_prompt = rms_norm(xp, final_norm_w)
    y_sample = rms_norm(xs, final_norm_w)
    new_state_hgrn = jnp.stack(ctx_states, axis=1).astype(state_hgrn.dtype)
    return (y_prompt, y_sample, new_state_hgrn)
```

```cpp
#include <hip/hip_runtime.h>
#include <cstdio>
#include <cstdint>
typedef float f32x2 __attribute__((ext_vector_type(2)));
namespace pg8 {
#define PG8_LAS __attribute__((address_space(3)))
typedef unsigned short bf16_t;
typedef short bf16x8 __attribute__((ext_vector_type(8)));
typedef float f32x4 __attribute__((ext_vector_type(4)));
typedef unsigned u32x4 __attribute__((ext_vector_type(4)));
constexpr int BM = 256, BK = 64, HALF = 128, HTB = HALF * BK * 2  , STAGE_BYTES = 8 * HTB, NXCD = 8, WGM = 8;

__host__ __device__ __forceinline__ int lds_byte(int r, int c) { const int st = (r >> 4) * 2 + (c >> 5), rr = r & 15, cc = c & 31, ob = rr * 64 + cc * 2; return st * 1024 + (ob ^ (((ob >> 9) & 1) << 5)); }
__host__ __device__ __forceinline__ void stage_rc(int b, int& R, int& C) { const int st = b / 1024, sb = b % 1024, swz = sb ^ (((sb >> 9) & 1) << 5); R = (st >> 1) * 16 + swz / 64; C = (st & 1) * 32 + (swz % 64) / 2; }
__host__ __device__ __forceinline__ int perm32(int rho) { const int n = rho >> 4, i = rho & 15; return 8 * (i >> 2) + 4 * n + (i & 3); }

struct Unit { int pm, pn; };
struct Gemm { const bf16_t* A; const bf16_t* Bt; int M, N, K; };

struct StaticOrder {
    int nM, nN, nwg, G, c;
    __host__ __device__ void init(int M, int N, int G_, int c_) { nM = M / BM; nN = N / BM; nwg = nM * nN; G = G_; c = c_; }
    __host__ __device__ bool next(int i, Unit& u) const {
        const long L = (long)i * G + c; if (L >= nwg) return false;
        int wgid = (int)L; { const int q = nwg / NXCD, r = nwg % NXCD, xcd = wgid % NXCD, off = wgid / NXCD; wgid = (xcd < r ? xcd * (q + 1) : r * (q + 1) + (xcd - r) * q) + off; }
        const int nig = WGM * nN, gid = wgid / nig, fm = gid * WGM, gsz = (nM - fm) < WGM ? (nM - fm) : WGM;
        u.pm = fm + ((wgid % nig) % gsz); u.pn = (wgid % nig) / gsz; return true;
    }
    __device__ __forceinline__ void a_ready(const Unit&) const {}
    __device__ __forceinline__ void done(const Unit&) const {}
};

template <class Epi, class Sched, bool ALIGN_EPI = false, bool SP2 = false>
__device__ __forceinline__ void gemm_phase(PG8_LAS unsigned char* lds, const Gemm g, const Sched& S, const Epi& E) {
    int tid_ = threadIdx.x; asm volatile("" : "+v"(tid_));
    const int tid = tid_, wid = __builtin_amdgcn_readfirstlane(tid >> 6), lane = tid & 63, wr = wid >> 2, wc = wid & 3, fr = lane & 15, fq = lane >> 4;
    const int K = g.K, nt = K / BK;
    unsigned voffA[2], voffB[2];
#pragma unroll
    for (int i = 0; i < 2; ++i) { int R, C; stage_rc(tid * 16 + i * 8192, R, C); const int Rb = Epi::PERM ? ((R & ~31) + perm32(R & 31)) : R;
        voffA[i] = (unsigned)(R * K + C) * 2u; voffB[i] = (unsigned)(Rb * K + C) * 2u; }
    const size_t kstep = (size_t)(BK * 2);
    const size_t hstep = (size_t)HALF * K * 2;
    const size_t tstep = 2 * hstep;
    const unsigned ldsw = (unsigned)wid * 1024u;
    const int aoff = lds_byte(wr * 64 + fr, fq * 8), boff = lds_byte(wc * 32 + fr, fq * 8);
#define PG8_SA(b, h) (((b) * 2 + (h)) * HTB)
#define PG8_SB(b, h) ((4 + (b) * 2 + (h)) * HTB)
#define PG8_STAGE(bufoff, gbase, voff) do { _Pragma("unroll") for (int _i = 0; _i < 2; ++_i) \
        __builtin_amdgcn_global_load_lds((const unsigned*)((const char*)(gbase) + (voff)[_i]), (PG8_LAS unsigned*)(lds + (bufoff) + ldsw + _i * 8192), 16, 0, 0); } while (0)
#define PG8_LDA(dst, b, h) do { _Pragma("unroll") for (int m = 0; m < 4; ++m) _Pragma("unroll") for (int k = 0; k < 2; ++k) dst[m][k] = *(const PG8_LAS bf16x8*)(lds + PG8_SA(b, h) + aoff + m * 2048 + k * 1024); } while (0)
#define PG8_LDB(dst, b, h) do { _Pragma("unroll") for (int n = 0; n < 2; ++n) _Pragma("unroll") for (int k = 0; k < 2; ++k) dst[n][k] = *(const PG8_LAS bf16x8*)(lds + PG8_SB(b, h) + boff + n * 2048 + k * 1024); } while (0)
#define PG8_MMA(ai, bj, At, Bt) do { __builtin_amdgcn_s_setprio(1); _Pragma("unroll") for (int m = 0; m < 4; ++m) _Pragma("unroll") for (int n = 0; n < 2; ++n) _Pragma("unroll") for (int k = 0; k < 2; ++k) \
        acc[ai][bj][m][n] = __builtin_amdgcn_mfma_f32_16x16x32_bf16(Bt[n][k], At[m][k], acc[ai][bj][m][n], 0, 0, 0); __builtin_amdgcn_s_setprio(0); } while (0)
#define PG8_WAIT_V(n) asm volatile("s_waitcnt vmcnt(" #n ")" ::: "memory")
#define PG8_WAIT_L(n) asm volatile("s_waitcnt lgkmcnt(" #n ")" ::: "memory")
#define PG8_BAR __builtin_amdgcn_s_barrier()
#define PG8_SCHED __builtin_amdgcn_sched_barrier(0)
    Unit cur, nxt; int ui = 0;
    if (!S.next(0, cur)) return;
    f32x4 acc[2][2][4][2];
#pragma unroll
    for (int a = 0; a < 2; ++a)
#pragma unroll
        for (int b = 0; b < 2; ++b)
#pragma unroll
            for (int m = 0; m < 4; ++m)
#pragma unroll
                for (int n = 0; n < 2; ++n) acc[a][b][m][n] = (f32x4){0.f, 0.f, 0.f, 0.f};
    bf16x8 At[4][2], B0[2][2], B1[2][2];
    const char* cA = (const char*)g.A + (size_t)cur.pm * tstep; const char* cB = (const char*)g.Bt + (size_t)cur.pn * tstep;
    S.a_ready(cur);
    if constexpr (SP2) {
        PG8_STAGE(PG8_SB(0, 0), cB, voffB); PG8_STAGE(PG8_SB(0, 1), cB + hstep, voffB); PG8_STAGE(PG8_SA(0, 0), cA, voffA); PG8_STAGE(PG8_SA(0, 1), cA + hstep, voffA);
        if (wr == 1) PG8_BAR;
        PG8_WAIT_V(2); PG8_BAR;
        PG8_STAGE(PG8_SB(1, 0), cB + kstep, voffB); PG8_STAGE(PG8_SA(1, 0), cA + kstep, voffA); PG8_STAGE(PG8_SB(1, 1), cB + hstep + kstep, voffB);
        PG8_WAIT_V(6); PG8_BAR;
    } else {
        PG8_STAGE(PG8_SB(0, 0), cB, voffB); PG8_STAGE(PG8_SA(0, 0), cA, voffA); PG8_STAGE(PG8_SB(0, 1), cB + hstep, voffB); PG8_STAGE(PG8_SA(0, 1), cA + hstep, voffA);
        if (wr == 1) PG8_BAR;
        PG8_WAIT_V(4); PG8_BAR;
        PG8_STAGE(PG8_SB(1, 0), cB + kstep, voffB); PG8_STAGE(PG8_SA(1, 0), cA + kstep, voffA); PG8_STAGE(PG8_SB(1, 1), cB + hstep + kstep, voffB);
        PG8_WAIT_V(6); PG8_BAR;
    }
    for (;;) {
        const bool has_next = S.next(ui + 1, nxt);
        const char* nA = has_next ? (const char*)g.A + (size_t)nxt.pm * tstep : cA; const char* nB = has_next ? (const char*)g.Bt + (size_t)nxt.pn * tstep : cB;
        for (int t = 0; t < nt; t += 2) {
            const bool last = (t == nt - 2);
            const char* a1 = cA + (size_t)(t + 1) * kstep;
            const char* a2 = last ? nA : cA + (size_t)(t + 2) * kstep; const char* b2 = last ? nB : cB + (size_t)(t + 2) * kstep;
            const char* a3 = a2 + kstep; const char* b3 = b2 + kstep;
            if (last && has_next) S.a_ready(nxt);
            if constexpr (SP2) {
            PG8_LDB(B0, 0, 0); PG8_LDB(B1, 0, 1); PG8_SCHED; PG8_LDA(At, 0, 0); PG8_STAGE(PG8_SA(1, 1), a1 + hstep, voffA);
            PG8_WAIT_V(8); PG8_WAIT_L(0); PG8_BAR; PG8_MMA(0, 0, At, B0); PG8_MMA(0, 1, At, B1); PG8_BAR; PG8_SCHED;
            PG8_LDA(At, 0, 1); PG8_STAGE(PG8_SB(0, 0), b2, voffB); PG8_STAGE(PG8_SB(0, 1), b2 + hstep, voffB); PG8_STAGE(PG8_SA(0, 0), a2, voffA);
            PG8_WAIT_V(8); PG8_WAIT_L(0); PG8_BAR; PG8_MMA(1, 0, At, B0); PG8_MMA(1, 1, At, B1); PG8_BAR; PG8_SCHED;
            PG8_LDB(B0, 1, 0); PG8_LDB(B1, 1, 1); PG8_SCHED; PG8_LDA(At, 1, 0); PG8_STAGE(PG8_SA(0, 1), a2 + hstep, voffA);
            PG8_WAIT_V(8); PG8_WAIT_L(0); PG8_BAR; PG8_MMA(0, 0, At, B0); PG8_MMA(0, 1, At, B1); PG8_BAR; PG8_SCHED;
            PG8_LDA(At, 1, 1); PG8_STAGE(PG8_SB(1, 0), b3, voffB); PG8_STAGE(PG8_SB(1, 1), b3 + hstep, voffB); PG8_STAGE(PG8_SA(1, 0), a3, voffA);
            PG8_WAIT_V(8); PG8_WAIT_L(0); PG8_BAR; PG8_MMA(1, 0, At, B0); PG8_MMA(1, 1, At, B1); PG8_BAR; PG8_SCHED;
            } else {
            PG8_LDB(B0, 0, 0); PG8_SCHED; PG8_LDA(At, 0, 0); PG8_STAGE(PG8_SA(1, 1), a1 + hstep, voffA);
            PG8_WAIT_L(8); PG8_BAR; PG8_WAIT_L(0); PG8_MMA(0, 0, At, B0); PG8_BAR; PG8_SCHED;
            PG8_LDB(B1, 0, 1); PG8_STAGE(PG8_SB(0, 0), b2, voffB);
            PG8_BAR; PG8_WAIT_L(0); PG8_MMA(0, 1, At, B1); PG8_BAR;
            PG8_LDA(At, 0, 1); PG8_STAGE(PG8_SA(0, 0), a2, voffA);
            PG8_BAR; PG8_WAIT_L(0); PG8_MMA(1, 0, At, B0); PG8_BAR; PG8_SCHED;
            PG8_STAGE(PG8_SB(0, 1), b2 + hstep, voffB);
            PG8_WAIT_V(6); PG8_BAR; PG8_MMA(1, 1, At, B1); PG8_BAR;
            PG8_LDB(B0, 1, 0); PG8_SCHED; PG8_LDA(At, 1, 0); PG8_STAGE(PG8_SA(0, 1), a2 + hstep, voffA);
            PG8_WAIT_L(8); PG8_BAR; PG8_WAIT_L(0); PG8_MMA(0, 0, At, B0); PG8_BAR; PG8_SCHED;
            PG8_LDB(B1, 1, 1); PG8_STAGE(PG8_SB(1, 0), b3, voffB);
            PG8_BAR; PG8_WAIT_L(0); PG8_MMA(0, 1, At, B1); PG8_BAR;
            PG8_LDA(At, 1, 1); PG8_STAGE(PG8_SA(1, 0), a3, voffA);
            PG8_BAR; PG8_WAIT_L(0); PG8_MMA(1, 0, At, B0); PG8_BAR; PG8_SCHED;
            PG8_STAGE(PG8_SB(1, 1), b3 + hstep, voffB);
            PG8_WAIT_V(6); PG8_BAR; PG8_MMA(1, 1, At, B1); PG8_BAR;
            }
        }
        if constexpr (ALIGN_EPI) { if (wr == 0) PG8_BAR; }
        if constexpr (!Epi::AFTER_DRAIN) { E(acc, cur, wr, wc, fr, fq); S.done(cur); }
        if (!has_next) break;
#pragma unroll
        for (int a = 0; a < 2; ++a)
#pragma unroll
            for (int b = 0; b < 2; ++b)
#pragma unroll
                for (int m = 0; m < 4; ++m)
#pragma unroll
                    for (int n = 0; n < 2; ++n) acc[a][b][m][n] = (f32x4){0.f, 0.f, 0.f, 0.f};
        cur = nxt; cA = nA; cB = nB; ++ui;
        if constexpr (ALIGN_EPI) { if (wr == 1) PG8_BAR; }
    }
    PG8_WAIT_V(0);
    if constexpr (!ALIGN_EPI) { if (wr == 0) PG8_BAR; }
    PG8_BAR;
    if constexpr (Epi::AFTER_DRAIN) { E.fused(acc, cur, wr, wc, fr, fq, lds, wid, lane); S.done(cur); }
#undef PG8_SA
#undef PG8_SB
#undef PG8_STAGE
#undef PG8_LDA
#undef PG8_LDB
#undef PG8_MMA
#undef PG8_WAIT_V
#undef PG8_WAIT_L
#undef PG8_BAR
#undef PG8_SCHED
}
}

constexpr int NWAVES = 8;
constexpr int DM = 1024, NTOK = 16384, NCTX = 8192, DFF = 2816, NMODC = 6144;
constexpr float EPSN = 1e-6f;
constexpr size_t MiB = 1u << 20;
constexpr size_t PL = (size_t)NTOK * DM;
constexpr size_t WS_CTL = 0, CTL_ZERO_BYTES = 1 * MiB;
constexpr int    CW_BAR = 4096;
constexpr size_t WS_MODS = 64 * 1024;
constexpr size_t WS_LB = 512 * 1024;
constexpr size_t WS_W_HIN = 1 * MiB, WS_W_HOUT = 11 * MiB, WS_W_SIN = 13 * MiB, WS_W_SOUT = 19 * MiB;
constexpr size_t WS_W_UP0 = 21 * MiB, WS_W_UP1 = 32 * MiB, WS_W_DN0 = 43 * MiB, WS_W_DN1 = 43 * MiB + 5767168;
constexpr size_t WS_H = 54 * MiB;
constexpr size_t WS_BIG = 86 * MiB;
constexpr size_t WS_SEGD = 246 * MiB;
constexpr size_t WS_END = 256 * MiB;
static_assert(WS_W_DN1 + 5767168 == WS_H && WS_BIG + 5 * PL * 2 == WS_SEGD, "ws map");
constexpr int RING_BYTES = 131072, XCH_OFF = RING_BYTES, XCH_BYTES = 4096, MISC_OFF = XCH_OFF + XCH_BYTES, LDS_BYTES = 147456;

#define GAS __attribute__((address_space(1)))
#define LAS __attribute__((address_space(3)))
typedef unsigned short u16;
typedef unsigned u32x4 __attribute__((ext_vector_type(4)));
typedef unsigned u32x2 __attribute__((ext_vector_type(2)));
typedef float f32x4 __attribute__((ext_vector_type(4)));
typedef short bf16x8 __attribute__((ext_vector_type(8)));
typedef __bf16 bf16x2_t __attribute__((ext_vector_type(2)));
typedef _Float16 f16x2_t __attribute__((ext_vector_type(2)));
#define LBAR() do { asm volatile("s_waitcnt lgkmcnt(0)" ::: "memory"); __builtin_amdgcn_s_barrier(); asm volatile("" ::: "memory"); } while (0)

__device__ __forceinline__ unsigned pk2(float lo, float hi) { f32x2 v = {lo, hi}; bf16x2_t b = __builtin_convertvector(v, bf16x2_t); return __builtin_bit_cast(unsigned, b); }
__device__ __forceinline__ unsigned pkh2(float lo, float hi) { f32x2 v = {lo, hi}; f16x2_t b = __builtin_convertvector(v, f16x2_t); return __builtin_bit_cast(unsigned, b); }
__device__ __forceinline__ float bflo(unsigned u) { return __builtin_bit_cast(float, u << 16); }
__device__ __forceinline__ float bfhi(unsigned u) { return __builtin_bit_cast(float, u & 0xffff0000u); }
__device__ __forceinline__ float bf1(u16 u) { return __builtin_bit_cast(float, (unsigned)u << 16); }
__device__ __forceinline__ float hlo(unsigned u) { return (float)__builtin_bit_cast(_Float16, (u16)(u & 0xffffu)); }
__device__ __forceinline__ float hhi(unsigned u) { return (float)__builtin_bit_cast(_Float16, (u16)(u >> 16)); }
__device__ __forceinline__ float siluf(float x) { return x / (1.f + __expf(-x)); }
__device__ __forceinline__ float wave_sum(float v) {
#pragma unroll
    for (int o = 1; o < 64; o <<= 1) v += __shfl_xor(v, o);
    return v;
}
__device__ __forceinline__ int row_group(int row) { return row < NCTX ? 0 : 1 + ((row - NCTX) >> 12); }

#define XB_TMO      128
#define XB_XCNT(j)  (256  + 64 * (j))
#define XB_XSUB(j)  (1280 + 64 * (j))
#define XB_XGEN(j)  (2304 + 64 * (j))
#define XB_TOP      3328
#define XB_TOPGEN   3392
#define XCD_BAR_WORDS 3456
#define XB_SPIN_CAP (1u << 18)

__device__ __forceinline__ unsigned xb_ld(unsigned* p)              { return __hip_atomic_load(p, __ATOMIC_RELAXED, __HIP_MEMORY_SCOPE_AGENT); }
__device__ __forceinline__ unsigned xb_add(unsigned* p, unsigned v) { return __hip_atomic_fetch_add(p, v, __ATOMIC_RELAXED, __HIP_MEMORY_SCOPE_AGENT); }
__device__ __forceinline__ unsigned xb_xcc_id() { return (unsigned)__builtin_amdgcn_s_getreg((3 << 11) | 20) & 0xFu; }
#define XB_SPIN(cond, bar) do { unsigned _sp = 0; while (cond) { __builtin_amdgcn_s_sleep(1); \
    if ((++_sp & 255u) == 0u) { if (xb_ld(&(bar)[XB_TMO])) break; if (_sp > XB_SPIN_CAP) { atomicAdd(&(bar)[XB_TMO], 1u); break; } } } } while (0)

struct XcdBarrier {
    unsigned* bar; unsigned x;
    volatile LAS unsigned* st;
};

__device__ __forceinline__ XcdBarrier xcd_barrier_post(unsigned* bar, volatile LAS unsigned* st) {
    XcdBarrier b; b.bar = bar; b.x = xb_xcc_id(); b.st = st;
    if (threadIdx.x == 0) (void)xb_add(&bar[XB_XCNT(b.x)], 1u);
    return b;
}
__device__ __forceinline__ void xcd_barrier_complete(unsigned* bar, unsigned x, unsigned& nloc, unsigned& nx) {
    const unsigned G = gridDim.x * gridDim.y * gridDim.z;
    unsigned sum, cnt, mine, sp = 0u;
    for (;;) {
        sum = 0u; cnt = 0u; mine = 0u;
#pragma unroll
        for (unsigned j = 0; j < 16; ++j) { const unsigned c = xb_ld(&bar[XB_XCNT(j)]); sum += c; cnt += (c > 0u) ? 1u : 0u; mine = (j == x) ? c : mine; }
        if (sum == G) break;
        __builtin_amdgcn_s_sleep(1);
        if ((++sp & 255u) == 0u) { if (xb_ld(&bar[XB_TMO])) break; if (sp > XB_SPIN_CAP) { atomicAdd(&bar[XB_TMO], 1u); break; } }
    }
    nloc = mine > 0u ? mine : 1u; nx = cnt > 0u ? cnt : 1u;
}

__device__ __forceinline__ void xcd_barrier(const XcdBarrier& b) {
    asm volatile("s_waitcnt vmcnt(0)" ::: "memory");
    __syncthreads();
    if (threadIdx.x == 0) {
        unsigned* bar = b.bar;
        __builtin_amdgcn_s_waitcnt(0);
        unsigned nloc = b.st[0], nx = b.st[1];
        if (nloc == 0u) { xcd_barrier_complete(bar, b.x, nloc, nx); b.st[0] = nloc; b.st[1] = nx; }
        const unsigned old = xb_add(&bar[XB_XSUB(b.x)], 1u);
        const unsigned gen = old / nloc;
        if (old + 1u == (gen + 1u) * nloc) {
            __builtin_amdgcn_fence(__ATOMIC_RELEASE, "agent");
            asm volatile("s_waitcnt vmcnt(0)" ::: "memory");
            const unsigned og = xb_add(&bar[XB_TOP], 1u);
            const unsigned tg = og / nx;
            if (og + 1u == (tg + 1u) * nx) xb_add(&bar[XB_TOPGEN], 1u);
            else XB_SPIN(xb_ld(&bar[XB_TOPGEN]) == tg, bar);
            __builtin_amdgcn_fence(__ATOMIC_ACQUIRE, "agent");
            xb_add(&bar[XB_XGEN(b.x)], 1u);
            asm volatile("s_waitcnt vmcnt(0)" ::: "memory");
        } else {
            XB_SPIN(xb_ld(&bar[XB_XGEN(b.x)]) == gen, bar);
            __builtin_amdgcn_fence(__ATOMIC_ACQUIRE, "agent");
            asm volatile("s_waitcnt vmcnt(0)" ::: "memory");
        }
    }
    __syncthreads();
}

using pg8::Unit;

struct EpiProj {
    static constexpr bool PERM = true, AFTER_DRAIN = false;
    u16* planes; const float* lb;
    __device__ __forceinline__ void operator()(const f32x4 (&acc)[2][2][4][2], const Unit& u, int wr, int wc, int fr, int fq) const {
        const int plane = u.pn >> 2, colt = (u.pn & 3) * 256;
        u16* base = planes + (size_t)plane * PL;
        const int row0 = u.pm * 256 + wr * 64 + fr, col0 = colt + wc * 32 + 8 * fq;
        const bool isgate = (plane == 1 || plane == 2), issilu = (plane == 0 || plane == 4);
        f32x4 lbv[2][2];
#pragma unroll
        for (int bj = 0; bj < 2; ++bj)
#pragma unroll
            for (int n = 0; n < 2; ++n) lbv[bj][n] = isgate ? *(const f32x4*)(lb + (plane - 1) * 1024 + col0 + bj * 128 + 4 * n) : (f32x4){0.f, 0.f, 0.f, 0.f};
#pragma unroll
        for (int ai = 0; ai < 2; ++ai)
#pragma unroll
            for (int m = 0; m < 4; ++m) {
                u16* rowp = base + (size_t)(row0 + ai * 128 + m * 16) * DM + col0;
#pragma unroll
                for (int bj = 0; bj < 2; ++bj) {
                    float x[8];
#pragma unroll
                    for (int n = 0; n < 2; ++n)
#pragma unroll
                        for (int i = 0; i < 4; ++i) x[4 * n + i] = acc[ai][bj][m][n][i];
                    u32x4 w;
                    if (isgate) {
#pragma unroll
                        for (int e = 0; e < 8; ++e) { const float l = lbv[bj][e >> 2][e & 3]; const float sg = 1.f / (1.f + __expf(-x[e])); x[e] = __logf(l + (1.f - l) * sg); }
                        w.x = pkh2(x[0], x[1]); w.y = pkh2(x[2], x[3]); w.z = pkh2(x[4], x[5]); w.w = pkh2(x[6], x[7]);
                    } else {
                        if (issilu) {
#pragma unroll
                            for (int e = 0; e < 8; ++e) x[e] = siluf(x[e]);
                        }
                        w.x = pk2(x[0], x[1]); w.y = pk2(x[2], x[3]); w.z = pk2(x[4], x[5]); w.w = pk2(x[6], x[7]);
                    }
                    *(u32x4*)(rowp + bj * 128) = w;
                }
            }
    }
};

struct EpiRes {
    static constexpr bool PERM = false, AFTER_DRAIN = false;
    const float* resA; const float* resB; float* out; const float* gate;
    __device__ __forceinline__ void operator()(const f32x4 (&acc)[2][2][4][2], const Unit& u, int wr, int wc, int fr, int fq) const {
        const int row0 = u.pm * 256 + wr * 64 + fr, col0 = u.pn * 256 + wc * 32 + 4 * fq;
        const float* gp = gate + row_group(u.pm * 256) * NMODC + col0;
        f32x4 gv[2][2];
#pragma unroll
        for (int bj = 0; bj < 2; ++bj)
#pragma unroll
            for (int n = 0; n < 2; ++n) gv[bj][n] = *(const f32x4*)(gp + bj * 128 + n * 16);
#pragma unroll
        for (int ai = 0; ai < 2; ++ai)
#pragma unroll
            for (int m = 0; m < 4; ++m) {
                const int row = row0 + ai * 128 + m * 16;
                const float* rp = (row < NCTX ? resA + (size_t)row * DM : resB + (size_t)(row - NCTX) * DM) + col0;
                float* op = out + (size_t)row * DM + col0;
#pragma unroll
                for (int bj = 0; bj < 2; ++bj)
#pragma unroll
                    for (int n = 0; n < 2; ++n) { const f32x4 r = *(const f32x4*)(rp + bj * 128 + n * 16); *(f32x4*)(op + bj * 128 + n * 16) = r + gv[bj][n] * acc[ai][bj][m][n]; }
            }
    }
};

struct EpiFfnUp {
    static constexpr bool PERM = true, AFTER_DRAIN = false;
    u16* act; const float* cw; const float* cb; LAS float* xch;
    __device__ __forceinline__ void operator()(const f32x4 (&acc)[2][2][4][2], const Unit& u, int wr, int wc, int fr, int fq) const {
        const int lane = threadIdx.x & 63;
        const bool ctx = (u.pm * 256) < NCTX;
        const int colq = wc * 32 + 8 * fq;
        const int gcol = u.pn * 128 + colq;
        if (fr == 0 || fr == 15) {
#pragma unroll
            for (int ai = 0; ai < 2; ++ai) {
                const int m = fr == 0 ? 0 : 3;
                LAS float* p = xch + (((wr * 4 + wc) * 2 + ai) * 2 + (fr == 0 ? 0 : 1)) * 32 + 8 * fq;
                const f32x4 v0 = fr == 0 ? acc[ai][0][0][0] : acc[ai][0][3][0], v1 = fr == 0 ? acc[ai][0][0][1] : acc[ai][0][3][1]; (void)m;
                *(LAS f32x4*)p = v0; *(LAS f32x4*)(p + 4) = v1;
            }
        }
        LBAR();
        f32x4 w0[2], w1[2], w2[2], bb[2];
#pragma unroll
        for (int n = 0; n < 2; ++n) { w0[n] = *(const f32x4*)(cw + gcol + 4 * n); w1[n] = *(const f32x4*)(cw + DFF + gcol + 4 * n); w2[n] = *(const f32x4*)(cw + 2 * DFF + gcol + 4 * n); bb[n] = *(const f32x4*)(cb + gcol + 4 * n); }
        const int src_up = (lane & 48) | ((fr + 15) & 15), src_dn = (lane & 48) | ((fr + 1) & 15);
#pragma unroll
        for (int ai = 0; ai < 2; ++ai) {
            f32x4 xu[2], xd[2];
            {
                const bool has_u = ctx && (wr == 1 || ai == 1);
                const int uai = wr == 1 ? ai : 0;
                const LAS float* pu = xch + ((((1 - wr) * 4 + wc) * 2 + uai) * 2 + 1) * 32 + 8 * fq;
                const bool has_d = ctx && (wr == 0 || ai == 0);
                const int dai = wr == 0 ? ai : 1;
                const LAS float* pd = xch + ((((1 - wr) * 4 + wc) * 2 + dai) * 2 + 0) * 32 + 8 * fq;
#pragma unroll
                for (int n = 0; n < 2; ++n) {
                    const f32x4 a = *(const LAS f32x4*)(pu + 4 * n), b = *(const LAS f32x4*)(pd + 4 * n);
                    xu[n] = has_u ? a : (f32x4){0.f, 0.f, 0.f, 0.f}; xd[n] = has_d ? b : (f32x4){0.f, 0.f, 0.f, 0.f};
                }
            }
#pragma unroll
            for (int m = 0; m < 4; ++m) {
                u32x4 w; unsigned wv[4];
#pragma unroll
                for (int n = 0; n < 2; ++n) {
                    float o[4];
#pragma unroll
                    for (int i = 0; i < 4; ++i) {
                        const float a = acc[ai][0][m][n][i];
                        const float tu = (m > 0 && fr == 15) ? acc[ai][0][m > 0 ? m - 1 : 0][n][i] : a;
                        const float td = (m < 3 && fr == 0) ? acc[ai][0][m < 3 ? m + 1 : 3][n][i] : a;
                        float up = __shfl(tu, src_up), dn = __shfl(td, src_dn);
                        if (m == 0 && fr == 0) up = xu[n][i];
                        if (m == 3 && fr == 15) dn = xd[n][i];
                        const float cv = w0[n][i] * up + w1[n][i] * a + w2[n][i] * dn + bb[n][i];
                        o[i] = siluf(cv) * acc[ai][1][m][n][i];
                    }
                    wv[2 * n] = pk2(o[0], o[1]); wv[2 * n + 1] = pk2(o[2], o[3]);
                }
                w.x = wv[0]; w.y = wv[1]; w.z = wv[2]; w.w = wv[3];
                *(u32x4*)(act + (size_t)(u.pm * 256 + ai * 128 + wr * 64 + m * 16 + fr) * DFF + gcol) = w;
            }
        }
    }
};

struct EpiSconvIn {
    static constexpr bool PERM = true, AFTER_DRAIN = false;
    u16* cu; u16* gb;
    __device__ __forceinline__ void operator()(const f32x4 (&acc)[2][2][4][2], const Unit& u, int wr, int wc, int fr, int fq) const {
        const int row0 = u.pm * 256 + wr * 64 + fr, colq = wc * 32 + 8 * fq;
#pragma unroll
        for (int ai = 0; ai < 2; ++ai)
#pragma unroll
            for (int m = 0; m < 4; ++m) {
                const size_t ro = (size_t)(row0 + ai * 128 + m * 16) * DM;
                if (u.pn < 8) {
                    const f32x4 p0 = acc[ai][0][m][0] * acc[ai][1][m][0], p1 = acc[ai][0][m][1] * acc[ai][1][m][1];
                    u32x4 w; w.x = pk2(p0[0], p0[1]); w.y = pk2(p0[2], p0[3]); w.z = pk2(p1[0], p1[1]); w.w = pk2(p1[2], p1[3]);
                    *(u32x4*)(cu + ro + u.pn * 128 + colq) = w;
                } else {
#pragma unroll
                    for (int bj = 0; bj < 2; ++bj) { const f32x4 p0 = acc[ai][bj][m][0], p1 = acc[ai][bj][m][1];
                        u32x4 w; w.x = pk2(p0[0], p0[1]); w.y = pk2(p0[2], p0[3]); w.z = pk2(p1[0], p1[1]); w.w = pk2(p1[2], p1[3]);
                        *(u32x4*)(gb + ro + (u.pn - 8) * 256 + bj * 128 + colq) = w; }
                }
            }
    }
};

__device__ __forceinline__ void p0_transpose_item(const float* W, int K, int N, u16* WT, int mode, LAS float* scr, int item, int lane) {
    const int nblk = N / 32, kb = item / nblk, nb = item % nblk, k0 = 64 * kb, n0 = 32 * nb;
    int d0 = n0;
    if (mode == 1) { if (n0 < DFF) d0 = (n0 >> 7) * 256 + (n0 & 127); else { const int n1 = n0 - DFF; d0 = (n1 >> 7) * 256 + 128 + (n1 & 127); } }
    else if (mode == 2) { if (n0 < 1024) d0 = 2048 + n0; else if (n0 < 2048) { const int n1 = n0 - 1024; d0 = (n1 >> 7) * 256 + (n1 & 127); } else { const int n1 = n0 - 2048; d0 = (n1 >> 7) * 256 + 128 + (n1 & 127); } }
#pragma unroll 8
    for (int i = 0; i < 32; ++i) { const int kk = 2 * i + (lane >> 5); scr[kk * 33 + (lane & 31)] = W[(size_t)(k0 + kk) * N + n0 + (lane & 31)]; }
    asm volatile("s_waitcnt lgkmcnt(0)" ::: "memory");
    const int c = lane & 7;
#pragma unroll
    for (int j = 0; j < 4; ++j) { const int n = (lane >> 3) + 8 * j; const LAS float* s = scr + (8 * c) * 33 + n;
        u32x4 o; o.x = pk2(s[0 * 33], s[1 * 33]); o.y = pk2(s[2 * 33], s[3 * 33]); o.z = pk2(s[4 * 33], s[5 * 33]); o.w = pk2(s[6 * 33], s[7 * 33]);
        *(u32x4*)(WT + (size_t)(d0 + n) * K + k0 + 8 * c) = o; }
    asm volatile("s_waitcnt lgkmcnt(0)" ::: "memory");
}

__device__ __forceinline__ void modulate_rows(const float* xA, const float* xB, const float* nw, const float* mods_l, int ishift, int iscale, u16* H, int gw, int ngw, int lane) {
    for (int row = gw; row < NTOK; row += ngw) {
        const float* xr = (row < NCTX ? xA + (size_t)row * DM : xB + (size_t)(row - NCTX) * DM);
        const float* mg = mods_l + row_group(row) * NMODC;
        f32x4 v[4]; float ss = 0.f;
#pragma unroll
        for (int j = 0; j < 4; ++j) { v[j] = *(const f32x4*)(xr + 4 * lane + 256 * j); ss += (v[j][0] * v[j][0] + v[j][1] * v[j][1]) + (v[j][2] * v[j][2] + v[j][3] * v[j][3]); }
        const float rstd = 1.0f / sqrtf(wave_sum(ss) * (1.f / DM) + EPSN);
#pragma unroll
        for (int j = 0; j < 4; ++j) { const int c = 4 * lane + 256 * j;
            const f32x4 w = *(const f32x4*)(nw + c), sc = *(const f32x4*)(mg + iscale * 1024 + c), sh = *(const f32x4*)(mg + ishift * 1024 + c);
            const f32x4 o = (v[j] * rstd) * w * (sc + 1.0f) + sh;
            u32x2 p; p.x = pk2(o[0], o[1]); p.y = pk2(o[2], o[3]);
            *(u32x2*)(H + (size_t)row * DM + c) = p; }
    }
}

__device__ __forceinline__ void final_norm_rows(float* X, const float* nw, int gw, int ngw, int lane) {
    for (int row = gw; row < NTOK; row += ngw) {
        float* xr = X + (size_t)row * DM;
        f32x4 v[4]; float ss = 0.f;
#pragma unroll
        for (int j = 0; j < 4; ++j) { v[j] = *(const f32x4*)(xr + 4 * lane + 256 * j); ss += (v[j][0] * v[j][0] + v[j][1] * v[j][1]) + (v[j][2] * v[j][2] + v[j][3] * v[j][3]); }
        const float rstd = 1.0f / sqrtf(wave_sum(ss) * (1.f / DM) + EPSN);
#pragma unroll
        for (int j = 0; j < 4; ++j) { const int c = 4 * lane + 256 * j; const f32x4 w = *(const f32x4*)(nw + c); *(f32x4*)(xr + c) = (v[j] * rstd) * w; }
    }
}

__device__ __forceinline__ void mods_item(int mi, const float* c_ctx, const float* c, const float* ada_w, const float* ada_b, float* mods, LAS float* red, int tid) {
    const int wave = tid >> 6, lane = tid & 63;
    const int l = mi / 96, rem = mi % 96, cc = rem >> 2, kqr = rem & 3;
    const float* W = ada_w + (size_t)l * DM * NMODC + 256 * cc + 4 * lane;
    const int kbase = 256 * kqr + 32 * wave;
    f32x4 a0 = {0.f, 0.f, 0.f, 0.f}, a1 = a0, a2 = a0;
#pragma unroll 8
    for (int kk = 0; kk < 32; ++kk) {
        const int k = kbase + kk;
        const f32x4 w = *(const f32x4*)(W + (size_t)k * NMODC);
        const float s0 = siluf(c_ctx[k]), s1 = siluf(c[k]), s2 = siluf(c[DM + k]);
        a0 += w * s0; a1 += w * s1; a2 += w * s2;
    }
    *(LAS f32x4*)(red + (wave * 3 + 0) * 256 + 4 * lane) = a0;
    *(LAS f32x4*)(red + (wave * 3 + 1) * 256 + 4 * lane) = a1;
    *(LAS f32x4*)(red + (wave * 3 + 2) * 256 + 4 * lane) = a2;
    __syncthreads();
    for (int e = tid; e < 768; e += 512) {
        const int g = e >> 8, col = e & 255; float s = 0.f;
#pragma unroll
        for (int w = 0; w < 8; ++w) s += red[(w * 3 + g) * 256 + col];
        if (kqr == 0) s += ada_b[l * NMODC + 256 * cc + col];
        unsafeAtomicAdd(mods + (size_t)(l * 3 + g) * NMODC + 256 * cc + col, s);
    }
    __syncthreads();
}

constexpr int GL_QD = 0, GL_KI = 8704, GL_KST = 17408, GL_VT = 26624, GL_TOT = 35840, GL_DV = 39936, GL_RED = 40448;
__device__ __forceinline__ bf16x8 gl_frag(const LAS unsigned char* p) {
    const u32x2 a = *(const LAS u32x2*)p, b = *(const LAS u32x2*)(p + 32);
    u32x4 r; r.x = a.x; r.y = a.y; r.z = b.x; r.w = b.y; return __builtin_bit_cast(bf16x8, r);
}
__device__ __forceinline__ bf16x8 gl_pack(const f32x4& a, const f32x4& b) { u32x4 r; r.x = pk2(a[0], a[1]); r.y = pk2(a[2], a[3]); r.z = pk2(b[0], b[1]); r.w = pk2(b[2], b[3]); return __builtin_bit_cast(bf16x8, r); }

template <int MODE>
__device__ __forceinline__ void gla_pass(LAS unsigned char* L, const u16* Qp, const u16* Lp, const u16* Vp, u16* stash, const u16* Gp, u16* outp,
                                         int row0, int h, int dir, const float* Sinit, float* Sout, float* Dout, const float* gnw, int tid_in) {
    int tid = tid_in; asm volatile("" : "+v"(tid));
    const int wave = __builtin_amdgcn_readfirstlane(tid >> 6), lane = tid & 63, fr = lane & 15, kq = lane >> 4;
    const int hoff = h * 128;
    f32x4 S[8];
#pragma unroll
    for (int t = 0; t < 8; ++t)
#pragma unroll
        for (int i = 0; i < 4; ++i) S[t][i] = Sinit ? Sinit[(16 * t + 4 * kq + i) * 128 + 16 * wave + fr] : 0.f;
    float gs0 = 0.f, gs1 = 0.f;
    unsigned rq[4], rl[4], rv[4];
#define GLA_LOAD(ci) do { _Pragma("unroll") for (int j = 0; j < 4; ++j) { const int tau = 32 * (ci) + 4 * wave + j; const size_t ro = (size_t)(row0 + (dir ? 255 - tau : tau)) * DM + hoff + 2 * lane; \
        if (MODE != 0) rq[j] = *(const unsigned*)(Qp + ro); rl[j] = *(const unsigned*)(Lp + ro); rv[j] = *(const unsigned*)(Vp + ro); } } while (0)
    GLA_LOAD(0);
#pragma unroll 1
    for (int ci = 0; ci < 8; ++ci) {
        float q0[4], q1[4], c0[4], c1[4], k0[4], k1[4]; unsigned vc[4];
#pragma unroll
        for (int j = 0; j < 4; ++j) { if (MODE != 0) { q0[j] = bflo(rq[j]); q1[j] = bfhi(rq[j]); } else { q0[j] = 0.f; q1[j] = 0.f; }
            const float l0 = hlo(rl[j]), l1 = hhi(rl[j]); k0[j] = 1.f - __expf(l0); k1[j] = 1.f - __expf(l1);
            c0[j] = l0 + (j ? c0[j ? j - 1 : 0] : 0.f); c1[j] = l1 + (j ? c1[j ? j - 1 : 0] : 0.f); vc[j] = rv[j]; }
        if (ci < 7) GLA_LOAD(ci + 1);
        *(LAS f32x2*)(L + GL_TOT + (wave * 128 + 2 * lane) * 4) = (f32x2){c0[3], c1[3]};
        LBAR();
        float pre0 = 0.f, pre1 = 0.f, gl0 = 0.f, gl1 = 0.f;
#pragma unroll
        for (int g = 0; g < 8; ++g) { const f32x2 t = *(const LAS f32x2*)(L + GL_TOT + (g * 128 + 2 * lane) * 4); gl0 += t.x; gl1 += t.y; if (g < wave) { pre0 += t.x; pre1 += t.y; } }
        float ks0[4], ks1[4];
#pragma unroll
        for (int j = 0; j < 4; ++j) {
            const float g0 = pre0 + c0[j], g1 = pre1 + c1[j];
            ks0[j] = k0[j] * __expf(gl0 - g0); ks1[j] = k1[j] * __expf(gl1 - g1);
            if (MODE != 0) {
                const int s = 4 * wave + j;
                *(LAS unsigned*)(L + GL_QD + s * 272 + 4 * lane) = pk2(q0[j] * __expf(g0), q1[j] * __expf(g1));
                *(LAS unsigned*)(L + GL_KI + s * 272 + 4 * lane) = pk2(k0[j] * __expf(-g0), k1[j] * __expf(-g1));
            }
        }
        { u32x2 a, b; a.x = pk2(ks0[0], ks0[1]); a.y = pk2(ks0[2], ks0[3]); b.x = pk2(ks1[0], ks1[1]); b.y = pk2(ks1[2], ks1[3]);
          *(LAS u32x2*)(L + GL_KST + (2 * lane) * 72 + 8 * wave) = a; *(LAS u32x2*)(L + GL_KST + (2 * lane + 1) * 72 + 8 * wave) = b;
          u32x2 c, d; c.x = (vc[0] & 0xffffu) | (vc[1] << 16); c.y = (vc[2] & 0xffffu) | (vc[3] << 16); d.x = (vc[0] >> 16) | (vc[1] & 0xffff0000u); d.y = (vc[2] >> 16) | (vc[3] & 0xffff0000u);
          *(LAS u32x2*)(L + GL_VT + (2 * lane) * 72 + 8 * wave) = c; *(LAS u32x2*)(L + GL_VT + (2 * lane + 1) * 72 + 8 * wave) = d; }
        if (wave == 0) { *(LAS f32x2*)(L + GL_DV + 8 * lane) = (f32x2){__expf(gl0), __expf(gl1)}; gs0 += gl0; gs1 += gl1; }
        LBAR();
        const bf16x8 vb = gl_frag(L + GL_VT + (16 * wave + fr) * 72 + 8 * kq);
        f32x4 o[2] = {{0.f, 0.f, 0.f, 0.f}, {0.f, 0.f, 0.f, 0.f}};
        if (MODE != 0) {
            bf16x8 qf[2][4];
#pragma unroll
            for (int ct = 0; ct < 2; ++ct)
#pragma unroll
                for (int p = 0; p < 4; ++p) qf[ct][p] = gl_frag(L + GL_QD + (16 * ct + fr) * 272 + (32 * p + 4 * kq) * 2);
#pragma unroll
            for (int p = 0; p < 4; ++p) { const bf16x8 sb = gl_pack(S[2 * p], S[2 * p + 1]);
                o[0] = __builtin_amdgcn_mfma_f32_16x16x32_bf16(qf[0][p], sb, o[0], 0, 0, 0); o[1] = __builtin_amdgcn_mfma_f32_16x16x32_bf16(qf[1][p], sb, o[1], 0, 0, 0); }
            f32x4 s00 = {0.f, 0.f, 0.f, 0.f}, s01 = s00, s11 = s00;
#pragma unroll
            for (int p = 0; p < 4; ++p) {
                const bf16x8 kf0 = gl_frag(L + GL_KI + fr * 272 + (32 * p + 4 * kq) * 2), kf1 = gl_frag(L + GL_KI + (16 + fr) * 272 + (32 * p + 4 * kq) * 2);
                s00 = __builtin_amdgcn_mfma_f32_16x16x32_bf16(kf0, qf[0][p], s00, 0, 0, 0);
                s01 = __builtin_amdgcn_mfma_f32_16x16x32_bf16(kf0, qf[1][p], s01, 0, 0, 0);
                s11 = __builtin_amdgcn_mfma_f32_16x16x32_bf16(kf1, qf[1][p], s11, 0, 0, 0);
            }
#pragma unroll
            for (int i = 0; i < 4; ++i) if (4 * kq + i > fr) { s00[i] = 0.f; s11[i] = 0.f; }
            const f32x4 z4 = {0.f, 0.f, 0.f, 0.f};
            const bf16x8 pa0 = gl_pack(s00, z4), pa1 = gl_pack(s01, s11);
            o[0] = __builtin_amdgcn_mfma_f32_16x16x32_bf16(pa0, vb, o[0], 0, 0, 0); o[1] = __builtin_amdgcn_mfma_f32_16x16x32_bf16(pa1, vb, o[1], 0, 0, 0);
        }
#pragma unroll
        for (int t = 0; t < 8; ++t) {
            const f32x4 dv = *(const LAS f32x4*)(L + GL_DV + (16 * t + 4 * kq) * 4);
            const bf16x8 ka = gl_frag(L + GL_KST + (16 * t + fr) * 72 + 8 * kq);
            S[t] = S[t] * dv;
            S[t] = __builtin_amdgcn_mfma_f32_16x16x32_bf16(ka, vb, S[t], 0, 0, 0);
        }
        if (MODE == 1) {
#pragma unroll
            for (int ct = 0; ct < 2; ++ct)
#pragma unroll
                for (int i = 0; i < 4; ++i) { const int tau = 32 * ci + 16 * ct + 4 * kq + i; const size_t ro = (size_t)(row0 + (dir ? 255 - tau : tau)) * DM + hoff + 16 * wave + fr;
                    stash[ro] = (u16)(pk2(o[ct][i], 0.f) & 0xffffu); }
        }
        if (MODE == 2) {
            float ov[2][4]; size_t ro[2][4];
#pragma unroll
            for (int ct = 0; ct < 2; ++ct)
#pragma unroll
                for (int i = 0; i < 4; ++i) { const int tau = 32 * ci + 16 * ct + 4 * kq + i; ro[ct][i] = (size_t)(row0 + (dir ? 255 - tau : tau)) * DM + hoff + 16 * wave + fr;
                    ov[ct][i] = o[ct][i] + bf1(stash[ro[ct][i]]);
                    float ss = ov[ct][i] * ov[ct][i]; ss += __shfl_xor(ss, 1); ss += __shfl_xor(ss, 2); ss += __shfl_xor(ss, 4); ss += __shfl_xor(ss, 8);
                    if (fr == 0) *(LAS float*)(L + GL_RED + (wave * 32 + 16 * ct + 4 * kq + i) * 4) = ss; }
            const float gw_ = gnw[16 * wave + fr];
            float gv[2][4];
#pragma unroll
            for (int ct = 0; ct < 2; ++ct)
#pragma unroll
                for (int i = 0; i < 4; ++i) gv[ct][i] = bf1(Gp[ro[ct][i]]);
            LBAR();
#pragma unroll
            for (int ct = 0; ct < 2; ++ct)
#pragma unroll
                for (int i = 0; i < 4; ++i) { float tot = 0.f;
#pragma unroll
                    for (int w = 0; w < 8; ++w) tot += *(const LAS float*)(L + GL_RED + (w * 32 + 16 * ct + 4 * kq + i) * 4);
                    const float rstd = 1.0f / sqrtf(tot * (1.f / 128.f) + EPSN);
                    outp[ro[ct][i]] = (u16)(pk2(ov[ct][i] * rstd * gw_ * gv[ct][i], 0.f) & 0xffffu); }
        }
    }
#undef GLA_LOAD
    if (Sout) {
#pragma unroll
        for (int t = 0; t < 8; ++t)
#pragma unroll
            for (int i = 0; i < 4; ++i) Sout[(16 * t + 4 * kq + i) * 128 + 16 * wave + fr] = S[t][i];
    }
    if (MODE == 0 && wave == 0) { Dout[2 * lane] = __expf(gs0); Dout[2 * lane + 1] = __expf(gs1); }
    asm volatile("s_waitcnt vmcnt(0)" ::: "memory");
    __syncthreads();
}

__device__ __forceinline__ void sconv_rows(const u16* cu, const u16* gb, const float* cw, const float* cb, u16* A2, int gtid, int ngt) {
    for (int it = gtid; it < NTOK * 128; it += ngt) {
        const int row = it >> 7, c = (it & 127) * 8;
        bool hp, hn; int dlt;
        if (row < NCTX) { dlt = 1; const int t = row & 255; hp = t > 0; hn = t < 255; }
        else { dlt = 64; const int t = (row - NCTX) & 4095; hp = t >= 64; hn = t < 4096 - 64; }
        const u32x4 z = {0u, 0u, 0u, 0u};
        const u32x4 m = *(const u32x4*)(cu + (size_t)row * DM + c);
        const u32x4 p = hp ? *(const u32x4*)(cu + (size_t)(row - dlt) * DM + c) : z;
        const u32x4 n = hn ? *(const u32x4*)(cu + (size_t)(row + dlt) * DM + c) : z;
        const u32x4 g = *(const u32x4*)(gb + (size_t)row * DM + c);
        float w0[8], w1[8], w2[8], bb[8];
#pragma unroll
        for (int q = 0; q < 2; ++q) { const f32x4 a = *(const f32x4*)(cw + c + 4 * q), b = *(const f32x4*)(cw + DM + c + 4 * q), d = *(const f32x4*)(cw + 2 * DM + c + 4 * q), e = *(const f32x4*)(cb + c + 4 * q);
#pragma unroll
            for (int i = 0; i < 4; ++i) { w0[4 * q + i] = a[i]; w1[4 * q + i] = b[i]; w2[4 * q + i] = d[i]; bb[4 * q + i] = e[i]; } }
        u32x4 o;
#pragma unroll
        for (int q = 0; q < 4; ++q) {
            const float zl = w0[2 * q] * bflo(p[q]) + w1[2 * q] * bflo(m[q]) + w2[2 * q] * bflo(n[q]) + bb[2 * q];
            const float zh = w0[2 * q + 1] * bfhi(p[q]) + w1[2 * q + 1] * bfhi(m[q]) + w2[2 * q + 1] * bfhi(n[q]) + bb[2 * q + 1];
            o[q] = pk2(zl * bflo(g[q]), zh * bfhi(g[q]));
        }
        *(u32x4*)(A2 + (size_t)row * DM + c) = o;
    }
}

#ifndef PH
#define PH 0x7fff
#endif
struct Args { const float* in[22]; float* out; unsigned char* ws; };
enum { I_XP = 0, I_XS, I_STATE, I_C, I_CCTX, I_ADAW, I_ADAB, I_NMIX, I_NFFN, I_HWIN, I_HLB, I_HGN, I_HWOUT, I_SWIN, I_SCW, I_SCB, I_SWOUT, I_FUP, I_FCW, I_FCB, I_FDN, I_FNW };

#define KAS __attribute__((address_space(4)))
#define GRID_BAR() xcd_barrier(bar)
#define PHASE_ENV() const KAS Args* ap_ = (const KAS Args*)__builtin_amdgcn_kernarg_segment_ptr(); asm volatile("" : "+s"(ap_)); \
    unsigned char* ws = ap_->ws; float* out = ap_->out; (void)ws; (void)out; \
    int tid_ = threadIdx.x; asm volatile("" : "+v"(tid_)); const int tid = tid_, lane = tid & 63, wave = __builtin_amdgcn_readfirstlane(tid >> 6); \
    const int G = gridDim.x, blk = blockIdx.x, gw = blk * NWAVES + wave, NGW = G * NWAVES; (void)lane; (void)gw; (void)NGW; \
    float* mods = (float*)(ws + WS_MODS); (void)mods
#define IN(k) (ap_->in[k])

__global__ void __launch_bounds__(NWAVES * 64, 2) hgrn_dit_fwd(Args args) {
    extern __shared__ __attribute__((aligned(16))) unsigned char lds[];
    LAS unsigned char* L = (LAS unsigned char*)lds;
    volatile LAS unsigned* MISC = (volatile LAS unsigned*)(L + MISC_OFF);
    for (int u = threadIdx.x; u < 32; u += NWAVES * 64) MISC[u] = 0u;
    __syncthreads();
    XcdBarrier bar = xcd_barrier_post((unsigned*)(args.ws + WS_CTL) + CW_BAR, MISC + 8);

    {
        PHASE_ENV();
        if (PH & 1) if (blk < 192) mods_item(blk, IN(I_CCTX), IN(I_C), IN(I_ADAW), IN(I_ADAB), mods, (LAS float*)L, tid);
        if (blk == G - 1) {
            const float* lbnd = IN(I_HLB);
            float* lbv = (float*)(ws + WS_LB);
            for (int e = tid; e < 2048; e += NWAVES * 64) { const int dir = e >> 10, i = e & 1023; lbv[e] = 1.f / (1.f + __expf(lbnd[dir * 2048 + 1024 + i] - lbnd[dir * 2048 + i])); }
        }
        LAS float* scr = (LAS float*)(L + wave * 16384);
        constexpr int I_A = (DM / 64) * (5120 / 32), I_B = (DM / 64) * (DM / 32), I_C2 = (DM / 64) * (3072 / 32), I_U = (DM / 64) * (2 * DFF / 32), I_D = (DFF / 64) * (DM / 32);
        constexpr int NITEMS = I_A + I_B + I_C2 + I_B + 2 * I_U + 2 * I_D;
        if (PH & 2) for (int it = gw; it < NITEMS; it += NGW) {
            int r = it;
            if (r < I_A) { p0_transpose_item(IN(I_HWIN), DM, 5120, (u16*)(ws + WS_W_HIN), 0, scr, r, lane); continue; } r -= I_A;
            if (r < I_B) { p0_transpose_item(IN(I_HWOUT), DM, DM, (u16*)(ws + WS_W_HOUT), 0, scr, r, lane); continue; } r -= I_B;
            if (r < I_C2) { p0_transpose_item(IN(I_SWIN), DM, 3072, (u16*)(ws + WS_W_SIN), 2, scr, r, lane); continue; } r -= I_C2;
            if (r < I_B) { p0_transpose_item(IN(I_SWOUT), DM, DM, (u16*)(ws + WS_W_SOUT), 0, scr, r, lane); continue; } r -= I_B;
            if (r < I_U) { p0_transpose_item(IN(I_FUP), DM, 2 * DFF, (u16*)(ws + WS_W_UP0), 1, scr, r, lane); continue; } r -= I_U;
            if (r < I_U) { p0_transpose_item(IN(I_FUP) + (size_t)DM * 2 * DFF, DM, 2 * DFF, (u16*)(ws + WS_W_UP1), 1, scr, r, lane); continue; } r -= I_U;
            if (r < I_D) { p0_transpose_item(IN(I_FDN), DFF, DM, (u16*)(ws + WS_W_DN0), 0, scr, r, lane); continue; } r -= I_D;
            p0_transpose_item(IN(I_FDN) + (size_t)DFF * DM, DFF, DM, (u16*)(ws + WS_W_DN1), 0, scr, r, lane);
        }
    }
    GRID_BAR();

#pragma unroll
    for (int layer = 0; layer < 2; ++layer) {
        if (PH & 4) { PHASE_ENV(); const float* mods_l = mods + (size_t)layer * 3 * NMODC; u16* Hb = (u16*)(ws + WS_H);
            if (layer == 0) modulate_rows(IN(I_XP), IN(I_XS), IN(I_NMIX), mods_l, 0, 1, Hb, gw, NGW, lane);
            else modulate_rows(out, out + (size_t)NCTX * DM, IN(I_NMIX) + DM, mods_l, 0, 1, Hb, gw, NGW, lane); }
        GRID_BAR();
        if (layer == 0) {
            if (PH & 8) { PHASE_ENV(); pg8::Gemm g{(const u16*)(ws + WS_H), (const u16*)(ws + WS_W_HIN), NTOK, 5120, DM}; pg8::StaticOrder S; S.init(NTOK, 5120, G, blk);
              EpiProj E{(u16*)(ws + WS_BIG), (const float*)(ws + WS_LB)};
              pg8::gemm_phase<EpiProj, pg8::StaticOrder, true, true>(L, g, S, E); }
            GRID_BAR();
            if (PH & 16) for (int idx = blockIdx.x; idx < 512; idx += gridDim.x) {
                PHASE_ENV(); u16* BIG = (u16*)(ws + WS_BIG); float* SEGKV = (float*)(ws + WS_H); float* SEGD = (float*)(ws + WS_SEGD);
                const int b = idx >> 8, h = (idx >> 5) & 7, dir = (idx >> 4) & 1, seg = idx & 15;
                if ((dir == 0 && seg == 15) || (dir == 1 && seg == 0)) continue;
                gla_pass<0>(L, nullptr, BIG + (dir ? 2 : 1) * PL, BIG + 3 * PL, nullptr, nullptr, nullptr, NCTX + b * 4096 + seg * 256, h, dir, nullptr, SEGKV + (size_t)idx * 16384, SEGD + (size_t)idx * 128, nullptr, tid);
            }
            GRID_BAR();
            if (PH & 32) for (int w = blockIdx.x; w < 256; w += gridDim.x) {
                PHASE_ENV(); float* SEGKV = (float*)(ws + WS_H); const float* SEGD = (const float*)(ws + WS_SEGD);
                const int chain = w >> 3, part = w & 7, e4 = (part * 512 + tid) * 4, d = e4 >> 7;
                const int dir = chain & 1, bh = chain >> 1;
                const int b = bh >> 3, h = bh & 7;
                f32x4 S = *(const f32x4*)(IN(I_STATE) + ((size_t)((b * 2 + dir) * 8 + h)) * 16384 + e4);
                f32x4 kv[15]; float dd[15];
#pragma unroll
                for (int k = 0; k < 15; ++k) { const int seg = dir ? 15 - k : k; kv[k] = *(const f32x4*)(SEGKV + ((size_t)chain * 16 + seg) * 16384 + e4); dd[k] = SEGD[((size_t)chain * 16 + seg) * 128 + d]; }
#pragma unroll
                for (int k = 0; k < 16; ++k) { const int seg = dir ? 15 - k : k; *(f32x4*)(SEGKV + ((size_t)chain * 16 + seg) * 16384 + e4) = S; if (k < 15) S = S * dd[k < 15 ? k : 0] + kv[k < 15 ? k : 0]; }
            }
            GRID_BAR();
            if (PH & 64) for (int it = blockIdx.x; it < 512; it += gridDim.x) {
                PHASE_ENV(); u16* BIG = (u16*)(ws + WS_BIG); const float* SEGKV = (const float*)(ws + WS_H);
                int row0, h; const float *sif = nullptr, *sib = nullptr; float *sof = nullptr, *sob = nullptr;
                if (it < 256) { const int b = it >> 3; h = it & 7; row0 = b * 256;
                    sof = out + (size_t)NTOK * DM + ((size_t)((b * 2 + 0) * 8 + h)) * 16384; sob = out + (size_t)NTOK * DM + ((size_t)((b * 2 + 1) * 8 + h)) * 16384; }
                else { const int idx = it - 256, b = idx >> 7, seg = idx & 15; h = (idx >> 4) & 7; row0 = NCTX + b * 4096 + seg * 256;
                    sif = SEGKV + ((size_t)(((b * 8 + h) * 2 + 0) * 16 + seg)) * 16384; sib = SEGKV + ((size_t)(((b * 8 + h) * 2 + 1) * 16 + seg)) * 16384; }
                gla_pass<1>(L, BIG, BIG + PL, BIG + 3 * PL, BIG + PL, nullptr, nullptr, row0, h, 0, sif, sof, nullptr, nullptr, tid);
                gla_pass<2>(L, BIG, BIG + 2 * PL, BIG + 3 * PL, BIG + PL, BIG + 4 * PL, BIG, row0, h, 1, sib, sob, nullptr, IN(I_HGN), tid);
            }
            GRID_BAR();
            if (PH & 128) { PHASE_ENV(); pg8::Gemm g{(const u16*)(ws + WS_BIG), (const u16*)(ws + WS_W_HOUT), NTOK, DM, DM}; pg8::StaticOrder S; S.init(NTOK, DM, G, blk);
              EpiRes E{IN(I_XP), IN(I_XS), out, mods + (size_t)layer * 3 * NMODC + 2 * 1024};
              pg8::gemm_phase<EpiRes, pg8::StaticOrder, true, true>(L, g, S, E); }
        } else {
            if (PH & 256) { PHASE_ENV(); u16* BIG = (u16*)(ws + WS_BIG); pg8::Gemm g{(const u16*)(ws + WS_H), (const u16*)(ws + WS_W_SIN), NTOK, 3072, DM}; pg8::StaticOrder S; S.init(NTOK, 3072, G, blk);
              EpiSconvIn E{BIG, BIG + PL};
              pg8::gemm_phase<EpiSconvIn, pg8::StaticOrder, true, true>(L, g, S, E); }
            GRID_BAR();
            if (PH & 512) { PHASE_ENV(); u16* BIG = (u16*)(ws + WS_BIG); sconv_rows(BIG, BIG + PL, IN(I_SCW), IN(I_SCB), BIG + 2 * PL, blk * NWAVES * 64 + tid, G * NWAVES * 64); }
            GRID_BAR();
            if (PH & 1024) { PHASE_ENV(); pg8::Gemm g{(const u16*)(ws + WS_BIG) + 2 * PL, (const u16*)(ws + WS_W_SOUT), NTOK, DM, DM}; pg8::StaticOrder S; S.init(NTOK, DM, G, blk);
              EpiRes E{out, out + (size_t)NCTX * DM, out, mods + (size_t)layer * 3 * NMODC + 2 * 1024};
              pg8::gemm_phase<EpiRes, pg8::StaticOrder, true, true>(L, g, S, E); }
        }
        GRID_BAR();
        if (PH & 2048) { PHASE_ENV(); modulate_rows(out, out + (size_t)NCTX * DM, IN(I_NFFN) + layer * DM, mods + (size_t)layer * 3 * NMODC, 3, 4, (u16*)(ws + WS_H), gw, NGW, lane); }
        GRID_BAR();
        if (PH & 4096) { PHASE_ENV(); pg8::Gemm g{(const u16*)(ws + WS_H), (const u16*)(ws + (layer ? WS_W_UP1 : WS_W_UP0)), NTOK, 2 * DFF, DM}; pg8::StaticOrder S; S.init(NTOK, 2 * DFF, G, blk);
          EpiFfnUp E{(u16*)(ws + WS_BIG), IN(I_FCW) + (size_t)layer * 3 * DFF, IN(I_FCB) + (size_t)layer * DFF, (LAS float*)(L + XCH_OFF)};
          pg8::gemm_phase<EpiFfnUp, pg8::StaticOrder, true, true>(L, g, S, E); }
        GRID_BAR();
        if (PH & 8192) { PHASE_ENV(); pg8::Gemm g{(const u16*)(ws + WS_BIG), (const u16*)(ws + (layer ? WS_W_DN1 : WS_W_DN0)), NTOK, DM, DFF}; pg8::StaticOrder S; S.init(NTOK, DM, G, blk);
          EpiRes E{out, out + (size_t)NCTX * DM, out, mods + (size_t)layer * 3 * NMODC + 5 * 1024};
          pg8::gemm_phase<EpiRes, pg8::StaticOrder, true, true>(L, g, S, E); }
        GRID_BAR();
    }
    if (PH & 16384) { PHASE_ENV(); final_norm_rows(out, IN(I_FNW), gw, NGW, lane); }
}

extern "C" void kernel_launch(void* const* d_in, const int* in_sizes, int n_in, void* d_out, int out_size, void* d_ws, size_t ws_size, hipStream_t stream) {
    static int grid = 0;
    if (grid == 0) {
        if (n_in != 22 || ws_size < WS_END) { fprintf(stderr, "kernel_launch: unexpected inputs (n_in %d, ws %zu)\n", n_in, ws_size); grid = -1; return; }
        int dev = 0, cus = 0, per_cu = 0;
        if (hipGetDevice(&dev) != hipSuccess || hipDeviceGetAttribute(&cus, hipDeviceAttributeMultiprocessorCount, dev) != hipSuccess) { grid = -1; return; }
        if (hipFuncSetAttribute((const void*)hgrn_dit_fwd, hipFuncAttributeMaxDynamicSharedMemorySize, LDS_BYTES) != hipSuccess) { fprintf(stderr, "kernel_launch: hipFuncSetAttribute failed\n"); grid = -1; return; }
        if (hipOccupancyMaxActiveBlocksPerMultiprocessor(&per_cu, (const void*)hgrn_dit_fwd, NWAVES * 64, LDS_BYTES) != hipSuccess || per_cu < 1) { fprintf(stderr, "kernel_launch: occupancy query says %d\n", per_cu); (void)hipGetLastError(); grid = -1; return; }
        grid = cus;
    }
    if (grid < 0) return;
    (void)hipMemsetAsync((char*)d_ws + WS_CTL, 0, CTL_ZERO_BYTES, stream);
    Args a{};
    for (int i = 0; i < 22; ++i) a.in[i] = (const float*)d_in[i];
    a.out = (float*)d_out; a.ws = (unsigned char*)d_ws;
    void* kargs[] = {&a};
    hipError_t e = hipLaunchCooperativeKernel((const void*)hgrn_dit_fwd, dim3(grid), dim3(NWAVES * 64), kargs, LDS_BYTES, stream);
    if (e != hipSuccess) fprintf(stderr, "kernel_launch: cooperative launch failed: %s (grid %d)\n", hipGetErrorString(e), grid);
}
```

```cpp
#include <hip/hip_runtime.h>
#include <cstdio>
#include <cstdint>
typedef float f32x2 __attribute__((ext_vector_type(2)));
namespace pg8 {
#define PG8_LAS __attribute__((address_space(3)))
typedef unsigned short bf16_t;
typedef short bf16x8 __attribute__((ext_vector_type(8)));
typedef float f32x4 __attribute__((ext_vector_type(4)));
typedef unsigned u32x4 __attribute__((ext_vector_type(4)));
constexpr int BM = 256, BK = 64, HALF = 128, HTB = HALF * BK * 2  , STAGE_BYTES = 8 * HTB, NXCD = 8, WGM = 8;

__host__ __device__ __forceinline__ int lds_byte(int r, int c) { const int st = (r >> 4) * 2 + (c >> 5), rr = r & 15, cc = c & 31, ob = rr * 64 + cc * 2; return st * 1024 + (ob ^ (((ob >> 9) & 1) << 5)); }
__host__ __device__ __forceinline__ void stage_rc(int b, int& R, int& C) { const int st = b / 1024, sb = b % 1024, swz = sb ^ (((sb >> 9) & 1) << 5); R = (st >> 1) * 16 + swz / 64; C = (st & 1) * 32 + (swz % 64) / 2; }
__host__ __device__ __forceinline__ int perm32(int rho) { const int n = rho >> 4, i = rho & 15; return 8 * (i >> 2) + 4 * n + (i & 3); }

struct Unit { int pm, pn; };
struct Gemm { const bf16_t* A; const bf16_t* Bt; int M, N, K; };

struct StaticOrder {
    int nM, nN, nwg, G, c;
    __host__ __device__ void init(int M, int N, int G_, int c_) { nM = M / BM; nN = N / BM; nwg = nM * nN; G = G_; c = c_; }
    __host__ __device__ bool next(int i, Unit& u) const {
        const long L = (long)i * G + c; if (L >= nwg) return false;
        int wgid = (int)L; { const int q = nwg / NXCD, r = nwg % NXCD, xcd = wgid % NXCD, off = wgid / NXCD; wgid = (xcd < r ? xcd * (q + 1) : r * (q + 1) + (xcd - r) * q) + off; }
        const int nig = WGM * nN, gid = wgid / nig, fm = gid * WGM, gsz = (nM - fm) < WGM ? (nM - fm) : WGM;
        u.pm = fm + ((wgid % nig) % gsz); u.pn = (wgid % nig) / gsz; return true;
    }
    __device__ __forceinline__ void a_ready(const Unit&) const {}
    __device__ __forceinline__ void done(const Unit&) const {}
};

template <class Epi, class Sched, bool ALIGN_EPI = false, bool SP2 = false>
__device__ __forceinline__ void gemm_phase(PG8_LAS unsigned char* lds, const Gemm g, const Sched& S, const Epi& E) {
    int tid_ = threadIdx.x; asm volatile("" : "+v"(tid_));
    const int tid = tid_, wid = __builtin_amdgcn_readfirstlane(tid >> 6), lane = tid & 63, wr = wid >> 2, wc = wid & 3, fr = lane & 15, fq = lane >> 4;
    const int K = g.K, nt = K / BK;
    unsigned voffA[2], voffB[2];
#pragma unroll
    for (int i = 0; i < 2; ++i) { int R, C; stage_rc(tid * 16 + i * 8192, R, C); const int Rb = Epi::PERM ? ((R & ~31) + perm32(R & 31)) : R;
        voffA[i] = (unsigned)(R * K + C) * 2u; voffB[i] = (unsigned)(Rb * K + C) * 2u; }
    const size_t kstep = (size_t)(BK * 2);
    const size_t hstep = (size_t)HALF * K * 2;
    const size_t tstep = 2 * hstep;
    const unsigned ldsw = (unsigned)wid * 1024u;
    const int aoff = lds_byte(wr * 64 + fr, fq * 8), boff = lds_byte(wc * 32 + fr, fq * 8);
#define PG8_SA(b, h) (((b) * 2 + (h)) * HTB)
#define PG8_SB(b, h) ((4 + (b) * 2 + (h)) * HTB)
#define PG8_STAGE(bufoff, gbase, voff) do { _Pragma("unroll") for (int _i = 0; _i < 2; ++_i) \
        __builtin_amdgcn_global_load_lds((const unsigned*)((const char*)(gbase) + (voff)[_i]), (PG8_LAS unsigned*)(lds + (bufoff) + ldsw + _i * 8192), 16, 0, 0); } while (0)
#define PG8_LDA(dst, b, h) do { _Pragma("unroll") for (int m = 0; m < 4; ++m) _Pragma("unroll") for (int k = 0; k < 2; ++k) dst[m][k] = *(const PG8_LAS bf16x8*)(lds + PG8_SA(b, h) + aoff + m * 2048 + k * 1024); } while (0)
#define PG8_LDB(dst, b, h) do { _Pragma("unroll") for (int n = 0; n < 2; ++n) _Pragma("unroll") for (int k = 0; k < 2; ++k) dst[n][k] = *(const PG8_LAS bf16x8*)(lds + PG8_SB(b, h) + boff + n * 2048 + k * 1024); } while (0)
#define PG8_MMA(ai, bj, At, Bt) do { __builtin_amdgcn_s_setprio(1); _Pragma("unroll") for (int m = 0; m < 4; ++m) _Pragma("unroll") for (int n = 0; n < 2; ++n) _Pragma("unroll") for (int k = 0; k < 2; ++k) \
        acc[ai][bj][m][n] = __builtin_amdgcn_mfma_f32_16x16x32_bf16(Bt[n][k], At[m][k], acc[ai][bj][m][n], 0, 0, 0); __builtin_amdgcn_s_setprio(0); } while (0)
#define PG8_WAIT_V(n) asm volatile("s_waitcnt vmcnt(" #n ")" ::: "memory")
#define PG8_WAIT_L(n) asm volatile("s_waitcnt lgkmcnt(" #n ")" ::: "memory")
#define PG8_BAR __builtin_amdgcn_s_barrier()
#define PG8_SCHED __builtin_amdgcn_sched_barrier(0)
    Unit cur, nxt; int ui = 0;
    if (!S.next(0, cur)) return;
    f32x4 acc[2][2][4][2];
#pragma unroll
    for (int a = 0; a < 2; ++a)
#pragma unroll
        for (int b = 0; b < 2; ++b)
#pragma unroll
            for (int m = 0; m < 4; ++m)
#pragma unroll
                for (int n = 0; n < 2; ++n) acc[a][b][m][n] = (f32x4){0.f, 0.f, 0.f, 0.f};
    bf16x8 At[4][2], B0[2][2], B1[2][2];
    const char* cA = (const char*)g.A + (size_t)cur.pm * tstep; const char* cB = (const char*)g.Bt + (size_t)cur.pn * tstep;
    S.a_ready(cur);
    if constexpr (SP2) {
        PG8_STAGE(PG8_SB(0, 0), cB, voffB); PG8_STAGE(PG8_SB(0, 1), cB + hstep, voffB); PG8_STAGE(PG8_SA(0, 0), cA, voffA); PG8_STAGE(PG8_SA(0, 1), cA + hstep, voffA);
        if (wr == 1) PG8_BAR;
        PG8_WAIT_V(2); PG8_BAR;
        PG8_STAGE(PG8_SB(1, 0), cB + kstep, voffB); PG8_STAGE(PG8_SA(1, 0), cA + kstep, voffA); PG8_STAGE(PG8_SB(1, 1), cB + hstep + kstep, voffB);
        PG8_WAIT_V(6); PG8_BAR;
    } else {
        PG8_STAGE(PG8_SB(0, 0), cB, voffB); PG8_STAGE(PG8_SA(0, 0), cA, voffA); PG8_STAGE(PG8_SB(0, 1), cB + hstep, voffB); PG8_STAGE(PG8_SA(0, 1), cA + hstep, voffA);
        if (wr == 1) PG8_BAR;
        PG8_WAIT_V(4); PG8_BAR;
        PG8_STAGE(PG8_SB(1, 0), cB + kstep, voffB); PG8_STAGE(PG8_SA(1, 0), cA + kstep, voffA); PG8_STAGE(PG8_SB(1, 1), cB + hstep + kstep, voffB);
        PG8_WAIT_V(6); PG8_BAR;
    }
    for (;;) {
        const bool has_next = S.next(ui + 1, nxt);
        const char* nA = has_next ? (const char*)g.A + (size_t)nxt.pm * tstep : cA; const char* nB = has_next ? (const char*)g.Bt + (size_t)nxt.pn * tstep : cB;
        for (int t = 0; t < nt; t += 2) {
            const bool last = (t == nt - 2);
            const char* a1 = cA + (size_t)(t + 1) * kstep;
            const char* a2 = last ? nA : cA + (size_t)(t + 2) * kstep; const char* b2 = last ? nB : cB + (size_t)(t + 2) * kstep;
            const char* a3 = a2 + kstep; const char* b3 = b2 + kstep;
            if (last && has_next) S.a_ready(nxt);
            if constexpr (SP2) {
            PG8_LDB(B0, 0, 0); PG8_LDB(B1, 0, 1); PG8_SCHED; PG8_LDA(At, 0, 0); PG8_STAGE(PG8_SA(1, 1), a1 + hstep, voffA);
            PG8_WAIT_V(8); PG8_WAIT_L(0); PG8_BAR; PG8_MMA(0, 0, At, B0); PG8_MMA(0, 1, At, B1); PG8_BAR; PG8_SCHED;
            PG8_LDA(At, 0, 1); PG8_STAGE(PG8_SB(0, 0), b2, voffB); PG8_STAGE(PG8_SB(0, 1), b2 + hstep, voffB); PG8_STAGE(PG8_SA(0, 0), a2, voffA);
            PG8_WAIT_V(8); PG8_WAIT_L(0); PG8_BAR; PG8_MMA(1, 0, At, B0); PG8_MMA(1, 1, At, B1); PG8_BAR; PG8_SCHED;
            PG8_LDB(B0, 1, 0); PG8_LDB(B1, 1, 1); PG8_SCHED; PG8_LDA(At, 1, 0); PG8_STAGE(PG8_SA(0, 1), a2 + hstep, voffA);
            PG8_WAIT_V(8); PG8_WAIT_L(0); PG8_BAR; PG8_MMA(0, 0, At, B0); PG8_MMA(0, 1, At, B1); PG8_BAR; PG8_SCHED;
            PG8_LDA(At, 1, 1); PG8_STAGE(PG8_SB(1, 0), b3, voffB); PG8_STAGE(PG8_SB(1, 1), b3 + hstep, voffB); PG8_STAGE(PG8_SA(1, 0), a3, voffA);
            PG8_WAIT_V(8); PG8_WAIT_L(0); PG8_BAR; PG8_MMA(1, 0, At, B0); PG8_MMA(1, 1, At, B1); PG8_BAR; PG8_SCHED;
            } else {
            PG8_LDB(B0, 0, 0); PG8_SCHED; PG8_LDA(At, 0, 0); PG8_STAGE(PG8_SA(1, 1), a1 + hstep, voffA);
            PG8_WAIT_L(8); PG8_BAR; PG8_WAIT_L(0); PG8_MMA(0, 0, At, B0); PG8_BAR; PG8_SCHED;
            PG8_LDB(B1, 0, 1); PG8_STAGE(PG8_SB(0, 0), b2, voffB);
            PG8_BAR; PG8_WAIT_L(0); PG8_MMA(0, 1, At, B1); PG8_BAR;
            PG8_LDA(At, 0, 1); PG8_STAGE(PG8_SA(0, 0), a2, voffA);
            PG8_BAR; PG8_WAIT_L(0); PG8_MMA(1, 0, At, B0); PG8_BAR; PG8_SCHED;
            PG8_STAGE(PG8_SB(0, 1), b2 + hstep, voffB);
            PG8_WAIT_V(6); PG8_BAR; PG8_MMA(1, 1, At, B1); PG8_BAR;
            PG8_LDB(B0, 1, 0); PG8_SCHED; PG8_LDA(At, 1, 0); PG8_STAGE(PG8_SA(0, 1), a2 + hstep, voffA);
            PG8_WAIT_L(8); PG8_BAR; PG8_WAIT_L(0); PG8_MMA(0, 0, At, B0); PG8_BAR; PG8_SCHED;
            PG8_LDB(B1, 1, 1); PG8_STAGE(PG8_SB(1, 0), b3, voffB);
            PG8_BAR; PG8_WAIT_L(0); PG8_MMA(0, 1, At, B1); PG8_BAR;
            PG8_LDA(At, 1, 1); PG8_STAGE(PG8_SA(1, 0), a3, voffA);
            PG8_BAR; PG8_WAIT_L(0); PG8_MMA(1, 0, At, B0); PG8_BAR; PG8_SCHED;
            PG8_STAGE(PG8_SB(1, 1), b3 + hstep, voffB);
            PG8_WAIT_V(6); PG8_BAR; PG8_MMA(1, 1, At, B1); PG8_BAR;
            }
        }
        if constexpr (ALIGN_EPI) { if (wr == 0) PG8_BAR; }
        if constexpr (!Epi::AFTER_DRAIN) { E(acc, cur, wr, wc, fr, fq); S.done(cur); }
        if (!has_next) break;
#pragma unroll
        for (int a = 0; a < 2; ++a)
#pragma unroll
            for (int b = 0; b < 2; ++b)
#pragma unroll
                for (int m = 0; m < 4; ++m)
#pragma unroll
                    for (int n = 0; n < 2; ++n) acc[a][b][m][n] = (f32x4){0.f, 0.f, 0.f, 0.f};
        cur = nxt; cA = nA; cB = nB; ++ui;
        if constexpr (ALIGN_EPI) { if (wr == 1) PG8_BAR; }
    }
    PG8_WAIT_V(0);
    if constexpr (!ALIGN_EPI) { if (wr == 0) PG8_BAR; }
    PG8_BAR;
    if constexpr (Epi::AFTER_DRAIN) { E.fused(acc, cur, wr, wc, fr, fq, lds, wid, lane); S.done(cur); }
#undef PG8_SA
#undef PG8_SB
#undef PG8_STAGE
#undef PG8_LDA
#undef PG8_LDB
#undef PG8_MMA
#undef PG8_WAIT_V
#undef PG8_WAIT_L
#undef PG8_BAR
#undef PG8_SCHED
}
}

constexpr int NWAVES = 8;
constexpr int DM = 1024, NTOK = 16384, NCTX = 8192, DFF = 2816, NMODC = 6144;
constexpr float EPSN = 1e-6f;
constexpr size_t MiB = 1u << 20;
constexpr size_t PL = (size_t)NTOK * DM;
constexpr size_t WS_CTL = 0, CTL_ZERO_BYTES = 1 * MiB;
constexpr int    CW_BAR = 4096;
constexpr size_t WS_MODS = 64 * 1024;
constexpr size_t WS_LB = 208 * 1024;
constexpr size_t WS_BIAS = 256 * 1024;
constexpr size_t WS_ROWSS = 247 * MiB;
constexpr int BIAS_STRIDE = 3 * 5632, RSS_STRIDE = 4 * NTOK;
constexpr size_t WS_W_HIN = 1 * MiB, WS_W_HOUT = 11 * MiB, WS_W_SIN = 13 * MiB, WS_W_SOUT = 19 * MiB;
constexpr size_t WS_W_UP0 = 21 * MiB, WS_W_UP1 = 32 * MiB, WS_W_DN0 = 43 * MiB, WS_W_DN1 = 43 * MiB + 5767168;
constexpr size_t WS_H = 54 * MiB;
constexpr size_t WS_BIG = 86 * MiB;
constexpr size_t WS_SEGD = 246 * MiB;
constexpr size_t WS_END = 256 * MiB;
static_assert(WS_W_DN1 + 5767168 == WS_H && WS_BIG + 5 * PL * 2 == WS_SEGD, "ws map");
constexpr int RING_BYTES = 131072, XCH_OFF = RING_BYTES, XCH_BYTES = 8192, MISC_OFF = XCH_OFF + XCH_BYTES, LDS_BYTES = 147456;

#define GAS __attribute__((address_space(1)))
#define LAS __attribute__((address_space(3)))
typedef unsigned short u16;
typedef unsigned u32x4 __attribute__((ext_vector_type(4)));
typedef unsigned u32x2 __attribute__((ext_vector_type(2)));
typedef float f32x4 __attribute__((ext_vector_type(4)));
typedef short bf16x8 __attribute__((ext_vector_type(8)));
typedef __bf16 bf16x2_t __attribute__((ext_vector_type(2)));
typedef _Float16 f16x2_t __attribute__((ext_vector_type(2)));
#define LBAR() do { asm volatile("s_waitcnt lgkmcnt(0)" ::: "memory"); __builtin_amdgcn_s_barrier(); asm volatile("" ::: "memory"); } while (0)

__device__ __forceinline__ unsigned pk2(float lo, float hi) { f32x2 v = {lo, hi}; bf16x2_t b = __builtin_convertvector(v, bf16x2_t); return __builtin_bit_cast(unsigned, b); }
__device__ __forceinline__ unsigned pkh2(float lo, float hi) { f32x2 v = {lo, hi}; f16x2_t b = __builtin_convertvector(v, f16x2_t); return __builtin_bit_cast(unsigned, b); }
__device__ __forceinline__ float bflo(unsigned u) { return __builtin_bit_cast(float, u << 16); }
__device__ __forceinline__ float bfhi(unsigned u) { return __builtin_bit_cast(float, u & 0xffff0000u); }
__device__ __forceinline__ float bf1(u16 u) { return __builtin_bit_cast(float, (unsigned)u << 16); }
__device__ __forceinline__ float hlo(unsigned u) { return (float)__builtin_bit_cast(_Float16, (u16)(u & 0xffffu)); }
__device__ __forceinline__ float hhi(unsigned u) { return (float)__builtin_bit_cast(_Float16, (u16)(u >> 16)); }
__device__ __forceinline__ float siluf(float x) { return x / (1.f + __expf(-x)); }
__device__ __forceinline__ float wave_sum(float v) {
#pragma unroll
    for (int o = 1; o < 64; o <<= 1) v += __shfl_xor(v, o);
    return v;
}
__device__ __forceinline__ int row_group(int row) { return row < NCTX ? 0 : 1 + ((row - NCTX) >> 12); }

#define XB_TMO      128
#define XB_XCNT(j)  (256  + 64 * (j))
#define XB_XSUB(j)  (1280 + 64 * (j))
#define XB_XGEN(j)  (2304 + 64 * (j))
#define XB_TOP      3328
#define XB_TOPGEN   3392
#define XCD_BAR_WORDS 3456
#define XB_SPIN_CAP (1u << 18)

__device__ __forceinline__ unsigned xb_ld(unsigned* p)              { return __hip_atomic_load(p, __ATOMIC_RELAXED, __HIP_MEMORY_SCOPE_AGENT); }
__device__ __forceinline__ unsigned xb_add(unsigned* p, unsigned v) { return __hip_atomic_fetch_add(p, v, __ATOMIC_RELAXED, __HIP_MEMORY_SCOPE_AGENT); }
__device__ __forceinline__ unsigned xb_xcc_id() { return (unsigned)__builtin_amdgcn_s_getreg((3 << 11) | 20) & 0xFu; }
#define XB_SPIN(cond, bar) do { unsigned _sp = 0; while (cond) { __builtin_amdgcn_s_sleep(1); \
    if ((++_sp & 255u) == 0u) { if (xb_ld(&(bar)[XB_TMO])) break; if (_sp > XB_SPIN_CAP) { atomicAdd(&(bar)[XB_TMO], 1u); break; } } } } while (0)

struct XcdBarrier {
    unsigned* bar; unsigned x;
    volatile LAS unsigned* st;
};

__device__ __forceinline__ XcdBarrier xcd_barrier_post(unsigned* bar, volatile LAS unsigned* st) {
    XcdBarrier b; b.bar = bar; b.x = xb_xcc_id(); b.st = st;
    if (threadIdx.x == 0) (void)xb_add(&bar[XB_XCNT(b.x)], 1u);
    return b;
}
__device__ __forceinline__ void xcd_barrier_complete(unsigned* bar, unsigned x, unsigned& nloc, unsigned& nx) {
    const unsigned G = gridDim.x * gridDim.y * gridDim.z;
    unsigned sum, cnt, mine, sp = 0u;
    for (;;) {
        sum = 0u; cnt = 0u; mine = 0u;
#pragma unroll
        for (unsigned j = 0; j < 16; ++j) { const unsigned c = xb_ld(&bar[XB_XCNT(j)]); sum += c; cnt += (c > 0u) ? 1u : 0u; mine = (j == x) ? c : mine; }
        if (sum == G) break;
        __builtin_amdgcn_s_sleep(1);
        if ((++sp & 255u) == 0u) { if (xb_ld(&bar[XB_TMO])) break; if (sp > XB_SPIN_CAP) { atomicAdd(&bar[XB_TMO], 1u); break; } }
    }
    nloc = mine > 0u ? mine : 1u; nx = cnt > 0u ? cnt : 1u;
}

__device__ __forceinline__ void xcd_barrier(const XcdBarrier& b) {
    asm volatile("s_waitcnt vmcnt(0)" ::: "memory");
    __syncthreads();
    if (threadIdx.x == 0) {
        unsigned* bar = b.bar;
        __builtin_amdgcn_s_waitcnt(0);
        unsigned nloc = b.st[0], nx = b.st[1];
        if (nloc == 0u) { xcd_barrier_complete(bar, b.x, nloc, nx); b.st[0] = nloc; b.st[1] = nx; }
        const unsigned old = xb_add(&bar[XB_XSUB(b.x)], 1u);
        const unsigned gen = old / nloc;
        if (old + 1u == (gen + 1u) * nloc) {
            __builtin_amdgcn_fence(__ATOMIC_RELEASE, "agent");
            asm volatile("s_waitcnt vmcnt(0)" ::: "memory");
            const unsigned og = xb_add(&bar[XB_TOP], 1u);
            const unsigned tg = og / nx;
            if (og + 1u == (tg + 1u) * nx) xb_add(&bar[XB_TOPGEN], 1u);
            else XB_SPIN(xb_ld(&bar[XB_TOPGEN]) == tg, bar);
            __builtin_amdgcn_fence(__ATOMIC_ACQUIRE, "agent");
            xb_add(&bar[XB_XGEN(b.x)], 1u);
            asm volatile("s_waitcnt vmcnt(0)" ::: "memory");
        } else {
            XB_SPIN(xb_ld(&bar[XB_XGEN(b.x)]) == gen, bar);
            __builtin_amdgcn_fence(__ATOMIC_ACQUIRE, "agent");
            asm volatile("s_waitcnt vmcnt(0)" ::: "memory");
        }
    }
    __syncthreads();
}

using pg8::Unit;
__device__ __forceinline__ float rstd4(const float* p) { return 1.0f / sqrtf(((p[0] + p[NTOK]) + (p[2 * NTOK] + p[3 * NTOK])) * (1.f / DM) + EPSN); }

struct EpiProj {
    static constexpr bool PERM = true, AFTER_DRAIN = false;
    u16* planes; const float* lb; const float* rowss; const float* bias; LAS float* xch;
    __device__ __forceinline__ void operator()(const f32x4 (&acc)[2][2][4][2], const Unit& u, int wr, int wc, int fr_, int fq_) const {
        int fr = fr_, fq = fq_; asm volatile("" : "+v"(fr), "+v"(fq));
        const int plane = u.pn >> 2, colt = (u.pn & 3) * 256;
        const bool isgate = (plane == 1 || plane == 2), issilu = (plane == 0 || plane == 4);
        {
            int t = threadIdx.x; asm volatile("" : "+v"(t));
            if (t < 256) xch[1792 + t] = rstd4(rowss + u.pm * 256 + t);
            else if (t < 320) { const int c4 = (t - 256) * 4; *(LAS f32x4*)(xch + 1024 + c4) = *(const f32x4*)(bias + row_group(u.pm * 256) * 5632 + u.pn * 256 + c4); }
            else if (t < 384) { const int c4 = (t - 320) * 4; *(LAS f32x4*)(xch + 1280 + c4) = *(const f32x4*)(lb + (isgate ? (plane - 1) * 1024 : 0) + colt + c4); }
        }
        LBAR();
        u16* base = planes + (size_t)plane * PL;
        const int row0 = u.pm * 256 + wr * 64 + fr, col0 = colt + wc * 32 + 8 * fq;
        const LAS float* bl = xch + 1024 + wc * 32 + 8 * fq;
        const LAS float* ll = xch + 1280 + wc * 32 + 8 * fq;
        const LAS float* rl = xch + 1792 + wr * 64 + fr;
#pragma unroll
        for (int ai = 0; ai < 2; ++ai)
#pragma unroll
            for (int m = 0; m < 4; ++m) {
                u16* rowp = base + (size_t)(row0 + ai * 128 + m * 16) * DM + col0;
                const float rs = rl[ai * 128 + m * 16];
#pragma unroll
                for (int bj = 0; bj < 2; ++bj) {
                    float x[8];
#pragma unroll
                    for (int n = 0; n < 2; ++n) { const f32x4 bv = *(const LAS f32x4*)(bl + bj * 128 + 4 * n);
#pragma unroll
                        for (int i = 0; i < 4; ++i) x[4 * n + i] = acc[ai][bj][m][n][i] * rs + bv[i]; }
                    u32x4 w;
                    if (isgate) {
                        const f32x4 l0 = *(const LAS f32x4*)(ll + bj * 128), l1 = *(const LAS f32x4*)(ll + bj * 128 + 4);
#pragma unroll
                        for (int e = 0; e < 8; ++e) { const float l = e < 4 ? l0[e & 3] : l1[e & 3]; const float sg = 1.f / (1.f + __expf(-x[e])); x[e] = __logf(l + (1.f - l) * sg); }
                        w.x = pkh2(x[0], x[1]); w.y = pkh2(x[2], x[3]); w.z = pkh2(x[4], x[5]); w.w = pkh2(x[6], x[7]);
                    } else {
                        if (issilu) {
#pragma unroll
                            for (int e = 0; e < 8; ++e) x[e] = siluf(x[e]);
                        }
                        w.x = pk2(x[0], x[1]); w.y = pk2(x[2], x[3]); w.z = pk2(x[4], x[5]); w.w = pk2(x[6], x[7]);
                    }
                    *(u32x4*)(rowp + bj * 128) = w;
                }
            }
    }
};

template <int NEXT> struct EpiRes {
    static constexpr bool PERM = false, AFTER_DRAIN = false;
    const float* resA; const float* resB; float* out; const float* gate;
    u16* An; const float* nw; const float* scale; float* rowss; LAS float* xch;
    __device__ __forceinline__ void operator()(const f32x4 (&acc)[2][2][4][2], const Unit& u, int wr, int wc, int fr_, int fq_) const {
        int fr = fr_, fq = fq_; asm volatile("" : "+v"(fr), "+v"(fq));
        const int row0 = u.pm * 256 + wr * 64 + fr, col0 = u.pn * 256 + wc * 32 + 4 * fq;
        const int grp = row_group(u.pm * 256);
        const float* gp = gate + grp * NMODC + col0;
        f32x4 gv[2][2], wm[2][2];
#pragma unroll
        for (int bj = 0; bj < 2; ++bj)
#pragma unroll
            for (int n = 0; n < 2; ++n) { gv[bj][n] = *(const f32x4*)(gp + bj * 128 + n * 16);
                if (NEXT == 1) wm[bj][n] = *(const f32x4*)(nw + col0 + bj * 128 + n * 16) * (*(const f32x4*)(scale + grp * NMODC + col0 + bj * 128 + n * 16) + 1.0f); }
#pragma unroll
        for (int ai = 0; ai < 2; ++ai)
#pragma unroll
            for (int m = 0; m < 4; ++m) {
                const int row = row0 + ai * 128 + m * 16;
                const float* rp = (row < NCTX ? resA + (size_t)row * DM : resB + (size_t)(row - NCTX) * DM) + col0;
                float* op = out + (size_t)row * DM + col0;
                float ss = 0.f;
#pragma unroll
                for (int bj = 0; bj < 2; ++bj)
#pragma unroll
                    for (int n = 0; n < 2; ++n) { const f32x4 r = *(const f32x4*)(rp + bj * 128 + n * 16); const f32x4 o = r + gv[bj][n] * acc[ai][bj][m][n]; *(f32x4*)(op + bj * 128 + n * 16) = o;
                        if (NEXT >= 1) ss += (o[0] * o[0] + o[1] * o[1]) + (o[2] * o[2] + o[3] * o[3]);
                        if (NEXT == 1) { const f32x4 a = o * wm[bj][n]; u32x2 p; p.x = pk2(a[0], a[1]); p.y = pk2(a[2], a[3]); *(u32x2*)(An + (size_t)row * DM + col0 + bj * 128 + n * 16) = p; } }
                if (NEXT >= 1) { ss += __shfl_xor(ss, 16); ss += __shfl_xor(ss, 32); if (fq == 0) xch[wc * 256 + ai * 128 + wr * 64 + m * 16 + fr] = ss; }
            }
        if (NEXT >= 1) {
            LBAR();
            int t = threadIdx.x; asm volatile("" : "+v"(t));
            if (t < 256) rowss[(size_t)u.pn * NTOK + u.pm * 256 + t] = (xch[t] + xch[256 + t]) + (xch[512 + t] + xch[768 + t]);
        }
    }
};

struct EpiFfnUp {
    static constexpr bool PERM = true, AFTER_DRAIN = false;
    u16* act; const float* cw; const float* cb; LAS float* xch; const float* rowss; const float* bias;
    __device__ __forceinline__ void operator()(const f32x4 (&acc)[2][2][4][2], const Unit& u, int wr, int wc, int fr_, int fq_) const {
        int fr = fr_, fq = fq_; asm volatile("" : "+v"(fr), "+v"(fq));
        const int lane = (fq << 4) | fr;
        const bool ctx = (u.pm * 256) < NCTX;
        const int colq = wc * 32 + 8 * fq;
        const int gcol = u.pn * 128 + colq;
        {
            int t = threadIdx.x; asm volatile("" : "+v"(t));
            if (t < 256) xch[1792 + t] = rstd4(rowss + u.pm * 256 + t);
            else if (t < 448) { const int q = t - 256, v = q >> 5, c4 = (q & 31) * 4; const float* bt = bias + row_group(u.pm * 256) * 5632 + u.pn * 256;
                const f32x4 x = v < 3 ? *(const f32x4*)(cw + v * DFF + u.pn * 128 + c4) : v == 3 ? *(const f32x4*)(cb + u.pn * 128 + c4) : *(const f32x4*)(bt + (v - 4) * 128 + c4);
                *(LAS f32x4*)(xch + 1024 + v * 128 + c4) = x; }
        }
        if (fr == 0 || fr == 15) {
#pragma unroll
            for (int ai = 0; ai < 2; ++ai) {
                LAS float* p = xch + (((wr * 4 + wc) * 2 + ai) * 2 + (fr == 0 ? 0 : 1)) * 32 + 8 * fq;
                *(LAS f32x4*)p = fr == 0 ? acc[ai][0][0][0] : acc[ai][0][3][0]; *(LAS f32x4*)(p + 4) = fr == 0 ? acc[ai][0][0][1] : acc[ai][0][3][1];
            }
        }
        LBAR();
        const int src_up = (lane & 48) | ((fr + 15) & 15), src_dn = (lane & 48) | ((fr + 1) & 15);
        const LAS float* cwl = xch + 1024 + colq;
        const LAS float* rl = xch + 1792;
#pragma unroll
        for (int ai = 0; ai < 2; ++ai) {
            const bool has_u = ctx && (wr == 1 || ai == 1);
            const int uai = wr == 1 ? ai : 0;
            const bool has_d = ctx && (wr == 0 || ai == 0);
            const int dai = wr == 0 ? ai : 1;
            const LAS float* pu = xch + ((((1 - wr) * 4 + wc) * 2 + uai) * 2 + 1) * 32 + 8 * fq;
            const LAS float* pd = xch + ((((1 - wr) * 4 + wc) * 2 + dai) * 2 + 0) * 32 + 8 * fq;
            const int rbase = ai * 128 + wr * 64;
            const float rsu = has_u ? rl[rbase - 1] : 0.f, rsd = has_d ? rl[rbase + 64] : 0.f;
            float rs[4];
#pragma unroll
            for (int m = 0; m < 4; ++m) rs[m] = rl[rbase + m * 16 + fr];
#define FU_A(m, n, i) (acc[ai][0][m][n][i] * rs[m] + ba[i])
#pragma unroll
            for (int m = 0; m < 4; ++m) {
                unsigned wv[4];
#pragma unroll
                for (int n = 0; n < 2; ++n) {
                    const f32x4 ba = *(const LAS f32x4*)(cwl + 4 * 128 + 4 * n), bgq = *(const LAS f32x4*)(cwl + 5 * 128 + 4 * n);
                    const f32x4 w0q = *(const LAS f32x4*)(cwl + 4 * n), w1q = *(const LAS f32x4*)(cwl + 128 + 4 * n), w2q = *(const LAS f32x4*)(cwl + 256 + 4 * n), bbq = *(const LAS f32x4*)(cwl + 384 + 4 * n);
                    float o[4];
#pragma unroll
                    for (int i = 0; i < 4; ++i) {
                        const float a = FU_A(m, n, i);
                        const float tu = (m > 0 && fr == 15) ? FU_A((m > 0 ? m - 1 : 0), n, i) : a;
                        const float td = (m < 3 && fr == 0) ? FU_A((m < 3 ? m + 1 : 3), n, i) : a;
                        float up = __shfl(tu, src_up), dn = __shfl(td, src_dn);
                        if (m == 0) { const float x = has_u ? pu[4 * n + i] * rsu + ba[i] : 0.f; if (fr == 0) up = x; }
                        if (m == 3) { const float x = has_d ? pd[4 * n + i] * rsd + ba[i] : 0.f; if (fr == 15) dn = x; }
                        const float cv = w0q[i] * up + w1q[i] * a + w2q[i] * dn + bbq[i];
                        o[i] = siluf(cv) * (acc[ai][1][m][n][i] * rs[m] + bgq[i]);
                    }
                    wv[2 * n] = pk2(o[0], o[1]); wv[2 * n + 1] = pk2(o[2], o[3]);
                }
                u32x4 w; w.x = wv[0]; w.y = wv[1]; w.z = wv[2]; w.w = wv[3];
                *(u32x4*)(act + (size_t)(u.pm * 256 + ai * 128 + wr * 64 + m * 16 + fr) * DFF + gcol) = w;
            }
#undef FU_A
        }
    }
};

struct EpiSconvIn {
    static constexpr bool PERM = true, AFTER_DRAIN = false;
    u16* cu; u16* gb; const float* rowss; const float* bias; LAS float* xch;
    __device__ __forceinline__ void operator()(const f32x4 (&acc)[2][2][4][2], const Unit& u, int wr, int wc, int fr_, int fq_) const {
        int fr = fr_, fq = fq_; asm volatile("" : "+v"(fr), "+v"(fq));
        {
            int t = threadIdx.x; asm volatile("" : "+v"(t));
            if (t < 256) xch[1792 + t] = rstd4(rowss + u.pm * 256 + t);
            else if (t < 320) { const int c4 = (t - 256) * 4; *(LAS f32x4*)(xch + 1024 + c4) = *(const f32x4*)(bias + row_group(u.pm * 256) * 5632 + u.pn * 256 + c4); }
        }
        LBAR();
        const int row0 = u.pm * 256 + wr * 64 + fr, colq = wc * 32 + 8 * fq;
        const LAS float* bl = xch + 1024 + colq;
        const LAS float* rl = xch + 1792 + wr * 64 + fr;
        const f32x4 b00 = *(const LAS f32x4*)(bl), b01 = *(const LAS f32x4*)(bl + 4), b10 = *(const LAS f32x4*)(bl + 128), b11 = *(const LAS f32x4*)(bl + 132);
#pragma unroll
        for (int ai = 0; ai < 2; ++ai)
#pragma unroll
            for (int m = 0; m < 4; ++m) {
                const size_t ro = (size_t)(row0 + ai * 128 + m * 16) * DM;
                const float rs = rl[ai * 128 + m * 16];
                if (u.pn < 8) {
                    const f32x4 p0 = (acc[ai][0][m][0] * rs + b00) * (acc[ai][1][m][0] * rs + b10), p1 = (acc[ai][0][m][1] * rs + b01) * (acc[ai][1][m][1] * rs + b11);
                    u32x4 w; w.x = pk2(p0[0], p0[1]); w.y = pk2(p0[2], p0[3]); w.z = pk2(p1[0], p1[1]); w.w = pk2(p1[2], p1[3]);
                    *(u32x4*)(cu + ro + u.pn * 128 + colq) = w;
                } else {
#pragma unroll
                    for (int bj = 0; bj < 2; ++bj) { const f32x4 p0 = acc[ai][bj][m][0] * rs + (bj ? b10 : b00), p1 = acc[ai][bj][m][1] * rs + (bj ? b11 : b01);
                        u32x4 w; w.x = pk2(p0[0], p0[1]); w.y = pk2(p0[2], p0[3]); w.z = pk2(p1[0], p1[1]); w.w = pk2(p1[2], p1[3]);
                        *(u32x4*)(gb + ro + (u.pn - 8) * 256 + bj * 128 + colq) = w; }
                }
            }
    }
};

__device__ __forceinline__ void p0_transpose_item(const float* W, int K, int N, u16* WT, int mode, LAS float* scr, int item, int lane) {
    const int nblk = N / 32, kb = item / nblk, nb = item % nblk, k0 = 64 * kb, n0 = 32 * nb;
    int d0 = n0;
    if (mode == 1) { if (n0 < DFF) d0 = (n0 >> 7) * 256 + (n0 & 127); else { const int n1 = n0 - DFF; d0 = (n1 >> 7) * 256 + 128 + (n1 & 127); } }
    else if (mode == 2) { if (n0 < 1024) d0 = 2048 + n0; else if (n0 < 2048) { const int n1 = n0 - 1024; d0 = (n1 >> 7) * 256 + (n1 & 127); } else { const int n1 = n0 - 2048; d0 = (n1 >> 7) * 256 + 128 + (n1 & 127); } }
#pragma unroll 8
    for (int i = 0; i < 32; ++i) { const int kk = 2 * i + (lane >> 5); scr[kk * 33 + (lane & 31)] = W[(size_t)(k0 + kk) * N + n0 + (lane & 31)]; }
    asm volatile("s_waitcnt lgkmcnt(0)" ::: "memory");
    const int c = lane & 7;
#pragma unroll
    for (int j = 0; j < 4; ++j) { const int n = (lane >> 3) + 8 * j; const LAS float* s = scr + (8 * c) * 33 + n;
        u32x4 o; o.x = pk2(s[0 * 33], s[1 * 33]); o.y = pk2(s[2 * 33], s[3 * 33]); o.z = pk2(s[4 * 33], s[5 * 33]); o.w = pk2(s[6 * 33], s[7 * 33]);
        *(u32x4*)(WT + (size_t)(d0 + n) * K + k0 + 8 * c) = o; }
    asm volatile("s_waitcnt lgkmcnt(0)" ::: "memory");
}

__device__ __forceinline__ void premod_rows(const float* xA, const float* xB, const float* nw, const float* scale, u16* H, float* rowss, int gw, int ngw, int lane) {
    for (int row = gw; row < NTOK; row += ngw) {
        const float* xr = (row < NCTX ? xA + (size_t)row * DM : xB + (size_t)(row - NCTX) * DM);
        const float* sg = scale + row_group(row) * NMODC;
        f32x4 v[4]; float ss = 0.f;
#pragma unroll
        for (int j = 0; j < 4; ++j) { v[j] = *(const f32x4*)(xr + 4 * lane + 256 * j); ss += (v[j][0] * v[j][0] + v[j][1] * v[j][1]) + (v[j][2] * v[j][2] + v[j][3] * v[j][3]); }
        ss = wave_sum(ss);
        if (lane < 4) rowss[(size_t)lane * NTOK + row] = lane == 0 ? ss : 0.f;
#pragma unroll
        for (int j = 0; j < 4; ++j) { const int c = 4 * lane + 256 * j;
            const f32x4 w = *(const f32x4*)(nw + c), sc = *(const f32x4*)(sg + c);
            const f32x4 o = v[j] * w * (sc + 1.0f);
            u32x2 p; p.x = pk2(o[0], o[1]); p.y = pk2(o[2], o[3]);
            *(u32x2*)(H + (size_t)row * DM + c) = p; }
    }
}

__device__ __forceinline__ void bias_row(const u16* Wt, int n, const float* shift, float* bias, int lane) {
    const u16* wr = Wt + (size_t)n * DM;
    const u32x4 w0 = *(const u32x4*)(wr + 8 * lane), w1 = *(const u32x4*)(wr + 512 + 8 * lane);
    float wv[16];
#pragma unroll
    for (int q = 0; q < 4; ++q) { wv[2 * q] = bflo(w0[q]); wv[2 * q + 1] = bfhi(w0[q]); wv[8 + 2 * q] = bflo(w1[q]); wv[8 + 2 * q + 1] = bfhi(w1[q]); }
#pragma unroll
    for (int g = 0; g < 3; ++g) {
        const float* sp = shift + g * NMODC;
        float s = 0.f;
#pragma unroll
        for (int q = 0; q < 2; ++q) { const f32x4 a = *(const f32x4*)(sp + 8 * lane + 4 * q), b = *(const f32x4*)(sp + 512 + 8 * lane + 4 * q);
#pragma unroll
            for (int i = 0; i < 4; ++i) s += wv[4 * q + i] * a[i] + wv[8 + 4 * q + i] * b[i]; }
        s = wave_sum(s);
        if (lane == 0) bias[g * 5632 + n] = s;
    }
}

__device__ __forceinline__ void final_norm_rows(float* X, const float* nw, const float* rowss, int gw, int ngw, int lane) {
    for (int row = gw; row < NTOK; row += ngw) {
        float* xr = X + (size_t)row * DM;
        const float rstd = rstd4(rowss + row);
#pragma unroll
        for (int j = 0; j < 4; ++j) { const int c = 4 * lane + 256 * j; const f32x4 w = *(const f32x4*)(nw + c); const f32x4 v = *(const f32x4*)(xr + c); *(f32x4*)(xr + c) = (v * rstd) * w; }
    }
}

__device__ __forceinline__ void mods_item(int mi, const float* c_ctx, const float* c, const float* ada_w, const float* ada_b, float* mods, LAS float* red, int tid) {
    const int wave = tid >> 6, lane = tid & 63;
    const int l = mi / 96, rem = mi % 96, cc = rem >> 2, kqr = rem & 3;
    const float* W = ada_w + (size_t)l * DM * NMODC + 256 * cc + 4 * lane;
    const int kbase = 256 * kqr + 32 * wave;
    f32x4 a0 = {0.f, 0.f, 0.f, 0.f}, a1 = a0, a2 = a0;
#pragma unroll 8
    for (int kk = 0; kk < 32; ++kk) {
        const int k = kbase + kk;
        const f32x4 w = *(const f32x4*)(W + (size_t)k * NMODC);
        const float s0 = siluf(c_ctx[k]), s1 = siluf(c[k]), s2 = siluf(c[DM + k]);
        a0 += w * s0; a1 += w * s1; a2 += w * s2;
    }
    *(LAS f32x4*)(red + (wave * 3 + 0) * 256 + 4 * lane) = a0;
    *(LAS f32x4*)(red + (wave * 3 + 1) * 256 + 4 * lane) = a1;
    *(LAS f32x4*)(red + (wave * 3 + 2) * 256 + 4 * lane) = a2;
    __syncthreads();
    for (int e = tid; e < 768; e += 512) {
        const int g = e >> 8, col = e & 255; float s = 0.f;
#pragma unroll
        for (int w = 0; w < 8; ++w) s += red[(w * 3 + g) * 256 + col];
        if (kqr == 0) s += ada_b[l * NMODC + 256 * cc + col];
        unsafeAtomicAdd(mods + (size_t)(l * 3 + g) * NMODC + 256 * cc + col, s);
    }
    __syncthreads();
}

constexpr int GL_QD = 0, GL_KI = 8704, GL_KST = 17408, GL_VT = 26624, GL_TOT = 35840, GL_DV = 39936, GL_RED = 40448;
__device__ __forceinline__ bf16x8 gl_frag(const LAS unsigned char* p) {
    const u32x2 a = *(const LAS u32x2*)p, b = *(const LAS u32x2*)(p + 32);
    u32x4 r; r.x = a.x; r.y = a.y; r.z = b.x; r.w = b.y; return __builtin_bit_cast(bf16x8, r);
}
__device__ __forceinline__ bf16x8 gl_pack(const f32x4& a, const f32x4& b) { u32x4 r; r.x = pk2(a[0], a[1]); r.y = pk2(a[2], a[3]); r.z = pk2(b[0], b[1]); r.w = pk2(b[2], b[3]); return __builtin_bit_cast(bf16x8, r); }

template <int MODE>
__device__ __forceinline__ void gla_pass(LAS unsigned char* L, const u16* Qp, const u16* Lp, const u16* Vp, u16* stash, const u16* Gp, u16* outp,
                                         int row0, int h, int dir, const float* Sinit, float* Sout, float* Dout, const float* gnw, int tid_in) {
    int tid = tid_in; asm volatile("" : "+v"(tid));
    const int wave = __builtin_amdgcn_readfirstlane(tid >> 6), lane = tid & 63, fr = lane & 15, kq = lane >> 4;
    const int hoff = h * 128;
    f32x4 S[8];
#pragma unroll
    for (int t = 0; t < 8; ++t)
#pragma unroll
        for (int i = 0; i < 4; ++i) S[t][i] = Sinit ? Sinit[(16 * t + 4 * kq + i) * 128 + 16 * wave + fr] : 0.f;
    float gs0 = 0.f, gs1 = 0.f;
    unsigned rq[4], rl[4], rv[4]; u16 rs_[2][4], rg_[2][4];
#define GLA_LOAD(ci) do { _Pragma("unroll") for (int j = 0; j < 4; ++j) { const int tau = 32 * (ci) + 4 * wave + j; const size_t ro = (size_t)(row0 + (dir ? 255 - tau : tau)) * DM + hoff + 2 * lane; \
        if (MODE != 0) rq[j] = *(const unsigned*)(Qp + ro); rl[j] = *(const unsigned*)(Lp + ro); rv[j] = *(const unsigned*)(Vp + ro); } \
        if (MODE == 2) { _Pragma("unroll") for (int ct = 0; ct < 2; ++ct) _Pragma("unroll") for (int i = 0; i < 4; ++i) { const int tau = 32 * (ci) + 16 * ct + 4 * kq + i; \
            const size_t ro = (size_t)(row0 + (dir ? 255 - tau : tau)) * DM + hoff + 16 * wave + fr; rs_[ct][i] = stash[ro]; rg_[ct][i] = Gp[ro]; } } } while (0)
    GLA_LOAD(0);
#pragma unroll 1
    for (int ci = 0; ci < 8; ++ci) {
        float q0[4], q1[4], c0[4], c1[4], k0[4], k1[4]; unsigned vc[4];
#pragma unroll
        for (int j = 0; j < 4; ++j) { if (MODE != 0) { q0[j] = bflo(rq[j]); q1[j] = bfhi(rq[j]); } else { q0[j] = 0.f; q1[j] = 0.f; }
            const float l0 = hlo(rl[j]), l1 = hhi(rl[j]); k0[j] = 1.f - __expf(l0); k1[j] = 1.f - __expf(l1);
            c0[j] = l0 + (j ? c0[j ? j - 1 : 0] : 0.f); c1[j] = l1 + (j ? c1[j ? j - 1 : 0] : 0.f); vc[j] = rv[j]; }
        float st_[2][4], gg_[2][4];
        if (MODE == 2) {
#pragma unroll
            for (int ct = 0; ct < 2; ++ct)
#pragma unroll
                for (int i = 0; i < 4; ++i) { st_[ct][i] = bf1(rs_[ct][i]); gg_[ct][i] = bf1(rg_[ct][i]); }
        }
        if (ci < 7) GLA_LOAD(ci + 1);
        *(LAS f32x2*)(L + GL_TOT + (wave * 128 + 2 * lane) * 4) = (f32x2){c0[3], c1[3]};
        LBAR();
        float pre0 = 0.f, pre1 = 0.f, gl0 = 0.f, gl1 = 0.f;
#pragma unroll
        for (int g = 0; g < 8; ++g) { const f32x2 t = *(const LAS f32x2*)(L + GL_TOT + (g * 128 + 2 * lane) * 4); gl0 += t.x; gl1 += t.y; if (g < wave) { pre0 += t.x; pre1 += t.y; } }
        float ks0[4], ks1[4];
#pragma unroll
        for (int j = 0; j < 4; ++j) {
            const float g0 = pre0 + c0[j], g1 = pre1 + c1[j];
            ks0[j] = k0[j] * __expf(gl0 - g0); ks1[j] = k1[j] * __expf(gl1 - g1);
            if (MODE != 0) {
                const int s = 4 * wave + j;
                *(LAS unsigned*)(L + GL_QD + s * 272 + 4 * lane) = pk2(q0[j] * __expf(g0), q1[j] * __expf(g1));
                *(LAS unsigned*)(L + GL_KI + s * 272 + 4 * lane) = pk2(k0[j] * __expf(-g0), k1[j] * __expf(-g1));
            }
        }
        { u32x2 a, b; a.x = pk2(ks0[0], ks0[1]); a.y = pk2(ks0[2], ks0[3]); b.x = pk2(ks1[0], ks1[1]); b.y = pk2(ks1[2], ks1[3]);
          *(LAS u32x2*)(L + GL_KST + (2 * lane) * 72 + 8 * wave) = a; *(LAS u32x2*)(L + GL_KST + (2 * lane + 1) * 72 + 8 * wave) = b;
          u32x2 c, d; c.x = (vc[0] & 0xffffu) | (vc[1] << 16); c.y = (vc[2] & 0xffffu) | (vc[3] << 16); d.x = (vc[0] >> 16) | (vc[1] & 0xffff0000u); d.y = (vc[2] >> 16) | (vc[3] & 0xffff0000u);
          *(LAS u32x2*)(L + GL_VT + (2 * lane) * 72 + 8 * wave) = c; *(LAS u32x2*)(L + GL_VT + (2 * lane + 1) * 72 + 8 * wave) = d; }
        if (wave == 0) { *(LAS f32x2*)(L + GL_DV + 8 * lane) = (f32x2){__expf(gl0), __expf(gl1)}; gs0 += gl0; gs1 += gl1; }
        LBAR();
        const bf16x8 vb = gl_frag(L + GL_VT + (16 * wave + fr) * 72 + 8 * kq);
        f32x4 o[2] = {{0.f, 0.f, 0.f, 0.f}, {0.f, 0.f, 0.f, 0.f}};
        if (MODE != 0) {
            bf16x8 qf[2][4];
#pragma unroll
            for (int ct = 0; ct < 2; ++ct)
#pragma unroll
                for (int p = 0; p < 4; ++p) qf[ct][p] = gl_frag(L + GL_QD + (16 * ct + fr) * 272 + (32 * p + 4 * kq) * 2);
#pragma unroll
            for (int p = 0; p < 4; ++p) { const bf16x8 sb = gl_pack(S[2 * p], S[2 * p + 1]);
                o[0] = __builtin_amdgcn_mfma_f32_16x16x32_bf16(qf[0][p], sb, o[0], 0, 0, 0); o[1] = __builtin_amdgcn_mfma_f32_16x16x32_bf16(qf[1][p], sb, o[1], 0, 0, 0); }
            f32x4 s00 = {0.f, 0.f, 0.f, 0.f}, s01 = s00, s11 = s00;
#pragma unroll
            for (int p = 0; p < 4; ++p) {
                const bf16x8 kf0 = gl_frag(L + GL_KI + fr * 272 + (32 * p + 4 * kq) * 2), kf1 = gl_frag(L + GL_KI + (16 + fr) * 272 + (32 * p + 4 * kq) * 2);
                s00 = __builtin_amdgcn_mfma_f32_16x16x32_bf16(kf0, qf[0][p], s00, 0, 0, 0);
                s01 = __builtin_amdgcn_mfma_f32_16x16x32_bf16(kf0, qf[1][p], s01, 0, 0, 0);
                s11 = __builtin_amdgcn_mfma_f32_16x16x32_bf16(kf1, qf[1][p], s11, 0, 0, 0);
            }
#pragma unroll
            for (int i = 0; i < 4; ++i) if (4 * kq + i > fr) { s00[i] = 0.f; s11[i] = 0.f; }
            const f32x4 z4 = {0.f, 0.f, 0.f, 0.f};
            const bf16x8 pa0 = gl_pack(s00, z4), pa1 = gl_pack(s01, s11);
            o[0] = __builtin_amdgcn_mfma_f32_16x16x32_bf16(pa0, vb, o[0], 0, 0, 0); o[1] = __builtin_amdgcn_mfma_f32_16x16x32_bf16(pa1, vb, o[1], 0, 0, 0);
        }
#pragma unroll
        for (int t = 0; t < 8; ++t) {
            const f32x4 dv = *(const LAS f32x4*)(L + GL_DV + (16 * t + 4 * kq) * 4);
            const bf16x8 ka = gl_frag(L + GL_KST + (16 * t + fr) * 72 + 8 * kq);
            S[t] = S[t] * dv;
            S[t] = __builtin_amdgcn_mfma_f32_16x16x32_bf16(ka, vb, S[t], 0, 0, 0);
        }
        if (MODE == 1) {
#pragma unroll
            for (int ct = 0; ct < 2; ++ct)
#pragma unroll
                for (int i = 0; i < 4; ++i) { const int tau = 32 * ci + 16 * ct + 4 * kq + i; const size_t ro = (size_t)(row0 + (dir ? 255 - tau : tau)) * DM + hoff + 16 * wave + fr;
                    stash[ro] = (u16)(pk2(o[ct][i], 0.f) & 0xffffu); }
        }
        if (MODE == 2) {
            float ov[2][4], ssv[2][4];
#pragma unroll
            for (int ct = 0; ct < 2; ++ct)
#pragma unroll
                for (int i = 0; i < 4; ++i) { ov[ct][i] = o[ct][i] + st_[ct][i];
                    float ss = ov[ct][i] * ov[ct][i]; ss += __shfl_xor(ss, 1); ss += __shfl_xor(ss, 2); ss += __shfl_xor(ss, 4); ss += __shfl_xor(ss, 8); ssv[ct][i] = ss; }
            if (fr == 0) {
#pragma unroll
                for (int ct = 0; ct < 2; ++ct) *(LAS f32x4*)(L + GL_RED + (wave * 32 + 16 * ct + 4 * kq) * 4) = (f32x4){ssv[ct][0], ssv[ct][1], ssv[ct][2], ssv[ct][3]};
            }
            const float gw_ = gnw[16 * wave + fr];
            LBAR();
#pragma unroll
            for (int ct = 0; ct < 2; ++ct) {
                f32x4 tot = {0.f, 0.f, 0.f, 0.f};
#pragma unroll
                for (int w = 0; w < 8; ++w) tot += *(const LAS f32x4*)(L + GL_RED + (w * 32 + 16 * ct + 4 * kq) * 4);
#pragma unroll
                for (int i = 0; i < 4; ++i) { const int tau = 32 * ci + 16 * ct + 4 * kq + i; const size_t ro = (size_t)(row0 + (dir ? 255 - tau : tau)) * DM + hoff + 16 * wave + fr;
                    const float rstd = 1.0f / sqrtf(tot[i] * (1.f / 128.f) + EPSN);
                    outp[ro] = (u16)(pk2(ov[ct][i] * rstd * gw_ * gg_[ct][i], 0.f) & 0xffffu); }
            }
        }
    }
#undef GLA_LOAD
    if (Sout) {
#pragma unroll
        for (int t = 0; t < 8; ++t)
#pragma unroll
            for (int i = 0; i < 4; ++i) Sout[(16 * t + 4 * kq + i) * 128 + 16 * wave + fr] = S[t][i];
    }
    if (MODE == 0 && wave == 0) { Dout[2 * lane] = __expf(gs0); Dout[2 * lane + 1] = __expf(gs1); }
    asm volatile("s_waitcnt vmcnt(0)" ::: "memory");
    __syncthreads();
}

__device__ __forceinline__ void sconv_rows(const u16* cu, const u16* gb, const float* cw, const float* cb, u16* A2, int gtid, int ngt) {
    for (int it = gtid; it < NTOK * 128; it += ngt) {
        const int row = it >> 7, c = (it & 127) * 8;
        bool hp, hn; int dlt;
        if (row < NCTX) { dlt = 1; const int t = row & 255; hp = t > 0; hn = t < 255; }
        else { dlt = 64; const int t = (row - NCTX) & 4095; hp = t >= 64; hn = t < 4096 - 64; }
        const u32x4 z = {0u, 0u, 0u, 0u};
        const u32x4 m = *(const u32x4*)(cu + (size_t)row * DM + c);
        const u32x4 p = hp ? *(const u32x4*)(cu + (size_t)(row - dlt) * DM + c) : z;
        const u32x4 n = hn ? *(const u32x4*)(cu + (size_t)(row + dlt) * DM + c) : z;
        const u32x4 g = *(const u32x4*)(gb + (size_t)row * DM + c);
        float w0[8], w1[8], w2[8], bb[8];
#pragma unroll
        for (int q = 0; q < 2; ++q) { const f32x4 a = *(const f32x4*)(cw + c + 4 * q), b = *(const f32x4*)(cw + DM + c + 4 * q), d = *(const f32x4*)(cw + 2 * DM + c + 4 * q), e = *(const f32x4*)(cb + c + 4 * q);
#pragma unroll
            for (int i = 0; i < 4; ++i) { w0[4 * q + i] = a[i]; w1[4 * q + i] = b[i]; w2[4 * q + i] = d[i]; bb[4 * q + i] = e[i]; } }
        u32x4 o;
#pragma unroll
        for (int q = 0; q < 4; ++q) {
            const float zl = w0[2 * q] * bflo(p[q]) + w1[2 * q] * bflo(m[q]) + w2[2 * q] * bflo(n[q]) + bb[2 * q];
            const float zh = w0[2 * q + 1] * bfhi(p[q]) + w1[2 * q + 1] * bfhi(m[q]) + w2[2 * q + 1] * bfhi(n[q]) + bb[2 * q + 1];
            o[q] = pk2(zl * bflo(g[q]), zh * bfhi(g[q]));
        }
        *(u32x4*)(A2 + (size_t)row * DM + c) = o;
    }
}

#ifndef PROBE
#define PROBE 0
#endif
#ifndef PH
#define PH 0x7fff
#endif
struct Args { const float* in[22]; float* out; unsigned char* ws; };
enum { I_XP = 0, I_XS, I_STATE, I_C, I_CCTX, I_ADAW, I_ADAB, I_NMIX, I_NFFN, I_HWIN, I_HLB, I_HGN, I_HWOUT, I_SWIN, I_SCW, I_SCB, I_SWOUT, I_FUP, I_FCW, I_FCB, I_FDN, I_FNW };

#define KAS __attribute__((address_space(4)))
#define GRID_BAR() do { const KAS Args* bp_ = (const KAS Args*)__builtin_amdgcn_kernarg_segment_ptr(); asm volatile("" : "+s"(bp_)); \
    XcdBarrier b_; b_.bar = (unsigned*)(bp_->ws + WS_CTL) + CW_BAR; b_.x = xb_xcc_id(); b_.st = (volatile LAS unsigned*)((LAS unsigned char*)lds + MISC_OFF) + 8; xcd_barrier(b_); } while (0)
#define PHASE_ENV() const KAS Args* ap_ = (const KAS Args*)__builtin_amdgcn_kernarg_segment_ptr(); asm volatile("" : "+s"(ap_)); \
    unsigned char* ws = ap_->ws; float* out = ap_->out; (void)ws; (void)out; \
    int tid_ = threadIdx.x; asm volatile("" : "+v"(tid_)); const int tid = tid_, lane = tid & 63, wave = __builtin_amdgcn_readfirstlane(tid >> 6); \
    const int G = gridDim.x, blk = blockIdx.x, gw = blk * NWAVES + wave, NGW = G * NWAVES; (void)lane; (void)gw; (void)NGW; \
    float* mods = (float*)(ws + WS_MODS); (void)mods
#define IN(k) (ap_->in[k])

__global__ void __launch_bounds__(NWAVES * 64, 2) hgrn_dit_fwd(Args args) {
    extern __shared__ __attribute__((aligned(16))) unsigned char lds[];
    LAS unsigned char* L = (LAS unsigned char*)lds;
    volatile LAS unsigned* MISC = (volatile LAS unsigned*)(L + MISC_OFF);
    for (int u = threadIdx.x; u < 32; u += NWAVES * 64) MISC[u] = 0u;
    __syncthreads();
    (void)xcd_barrier_post((unsigned*)(args.ws + WS_CTL) + CW_BAR, MISC + 8);

    {
        PHASE_ENV();
        if (PH & 1) if (blk < 192) mods_item(blk, IN(I_CCTX), IN(I_C), IN(I_ADAW), IN(I_ADAB), mods, (LAS float*)L, tid);
        if (blk == G - 1) {
            const float* lbnd = IN(I_HLB);
            float* lbv = (float*)(ws + WS_LB);
            for (int e = tid; e < 2048; e += NWAVES * 64) { const int dir = e >> 10, i = e & 1023; lbv[e] = 1.f / (1.f + __expf(lbnd[dir * 2048 + 1024 + i] - lbnd[dir * 2048 + i])); }
        }
        LAS float* scr = (LAS float*)(L + wave * 16384);
        constexpr int I_A = (DM / 64) * (5120 / 32), I_B = (DM / 64) * (DM / 32), I_C2 = (DM / 64) * (3072 / 32), I_U = (DM / 64) * (2 * DFF / 32), I_D = (DFF / 64) * (DM / 32);
        constexpr int NITEMS = I_A + I_B + I_C2 + I_B + 2 * I_U + 2 * I_D;
        if (PH & 2) for (int it = gw; it < NITEMS; it += NGW) {
            int r = it;
            if (r < I_A) { p0_transpose_item(IN(I_HWIN), DM, 5120, (u16*)(ws + WS_W_HIN), 0, scr, r, lane); continue; } r -= I_A;
            if (r < I_B) { p0_transpose_item(IN(I_HWOUT), DM, DM, (u16*)(ws + WS_W_HOUT), 0, scr, r, lane); continue; } r -= I_B;
            if (r < I_C2) { p0_transpose_item(IN(I_SWIN), DM, 3072, (u16*)(ws + WS_W_SIN), 2, scr, r, lane); continue; } r -= I_C2;
            if (r < I_B) { p0_transpose_item(IN(I_SWOUT), DM, DM, (u16*)(ws + WS_W_SOUT), 0, scr, r, lane); continue; } r -= I_B;
            if (r < I_U) { p0_transpose_item(IN(I_FUP), DM, 2 * DFF, (u16*)(ws + WS_W_UP0), 1, scr, r, lane); continue; } r -= I_U;
            if (r < I_U) { p0_transpose_item(IN(I_FUP) + (size_t)DM * 2 * DFF, DM, 2 * DFF, (u16*)(ws + WS_W_UP1), 1, scr, r, lane); continue; } r -= I_U;
            if (r < I_D) { p0_transpose_item(IN(I_FDN), DFF, DM, (u16*)(ws + WS_W_DN0), 0, scr, r, lane); continue; } r -= I_D;
            p0_transpose_item(IN(I_FDN) + (size_t)DFF * DM, DFF, DM, (u16*)(ws + WS_W_DN1), 0, scr, r, lane);
        }
    }
    GRID_BAR();

    if (PH & 4) { PHASE_ENV(); float* rowss = (float*)(ws + WS_ROWSS); float* bias = (float*)(ws + WS_BIAS);
        premod_rows(IN(I_XP), IN(I_XS), IN(I_NMIX), mods + 1 * 1024, (u16*)(ws + WS_H), rowss, gw, NGW, lane);
        for (int r = gw; r < 5120 + 5632 + 3072 + 5632; r += NGW) {
            if (r < 5120) bias_row((const u16*)(ws + WS_W_HIN), r, mods + 0 * 1024, bias, lane);
            else if (r < 5120 + 5632) bias_row((const u16*)(ws + WS_W_UP0), r - 5120, mods + 3 * 1024, bias + BIAS_STRIDE, lane);
            else if (r < 5120 + 5632 + 3072) bias_row((const u16*)(ws + WS_W_SIN), r - 5120 - 5632, mods + 3 * NMODC + 0 * 1024, bias + 2 * BIAS_STRIDE, lane);
            else bias_row((const u16*)(ws + WS_W_UP1), r - 5120 - 5632 - 3072, mods + 3 * NMODC + 3 * 1024, bias + 3 * BIAS_STRIDE, lane);
        }
    }
    GRID_BAR();

#if PROBE == 3
    { PHASE_ENV();
        LAS float* scr = (LAS float*)(L + wave * 16384);
        constexpr int I_A = (DM / 64) * (5120 / 32), I_B = (DM / 64) * (DM / 32), I_C2 = (DM / 64) * (3072 / 32), I_U = (DM / 64) * (2 * DFF / 32), I_D = (DFF / 64) * (DM / 32);
        constexpr int NITEMS = I_A + I_B + I_C2 + I_B + 2 * I_U + 2 * I_D;
        if (PH & 2) for (int it = gw; it < NITEMS; it += NGW) {
            int r = it;
            if (r < I_A) { p0_transpose_item(IN(I_HWIN), DM, 5120, (u16*)(ws + WS_W_HIN), 0, scr, r, lane); continue; } r -= I_A;
            if (r < I_B) { p0_transpose_item(IN(I_HWOUT), DM, DM, (u16*)(ws + WS_W_HOUT), 0, scr, r, lane); continue; } r -= I_B;
            if (r < I_C2) { p0_transpose_item(IN(I_SWIN), DM, 3072, (u16*)(ws + WS_W_SIN), 2, scr, r, lane); continue; } r -= I_C2;
            if (r < I_B) { p0_transpose_item(IN(I_SWOUT), DM, DM, (u16*)(ws + WS_W_SOUT), 0, scr, r, lane); continue; } r -= I_B;
            if (r < I_U) { p0_transpose_item(IN(I_FUP), DM, 2 * DFF, (u16*)(ws + WS_W_UP0), 1, scr, r, lane); continue; } r -= I_U;
            if (r < I_U) { p0_transpose_item(IN(I_FUP) + (size_t)DM * 2 * DFF, DM, 2 * DFF, (u16*)(ws + WS_W_UP1), 1, scr, r, lane); continue; } r -= I_U;
            if (r < I_D) { p0_transpose_item(IN(I_FDN), DFF, DM, (u16*)(ws + WS_W_DN0), 0, scr, r, lane); continue; } r -= I_D;
            p0_transpose_item(IN(I_FDN) + (size_t)DFF * DM, DFF, DM, (u16*)(ws + WS_W_DN1), 0, scr, r, lane);
        }
    }
    GRID_BAR();
    if (PH & 4) { PHASE_ENV(); float* rowss = (float*)(ws + WS_ROWSS); float* bias = (float*)(ws + WS_BIAS);
        premod_rows(IN(I_XP), IN(I_XS), IN(I_NMIX), mods + 1 * 1024, (u16*)(ws + WS_H), rowss, gw, NGW, lane);
        for (int r = gw; r < 5120 + 5632 + 3072 + 5632; r += NGW) {
            if (r < 5120) bias_row((const u16*)(ws + WS_W_HIN), r, mods + 0 * 1024, bias, lane);
            else if (r < 5120 + 5632) bias_row((const u16*)(ws + WS_W_UP0), r - 5120, mods + 3 * 1024, bias + BIAS_STRIDE, lane);
            else if (r < 5120 + 5632 + 3072) bias_row((const u16*)(ws + WS_W_SIN), r - 5120 - 5632, mods + 3 * NMODC + 0 * 1024, bias + 2 * BIAS_STRIDE, lane);
            else bias_row((const u16*)(ws + WS_W_UP1), r - 5120 - 5632 - 3072, mods + 3 * NMODC + 3 * 1024, bias + 3 * BIAS_STRIDE, lane);
        }
    }
    GRID_BAR();

#endif
#pragma unroll
    for (int layer = 0; layer < 2; ++layer) {
        if (layer == 0) {
            for (int rp2_ = 0; rp2_ < (PROBE == 2 ? 2 : 1); ++rp2_) {
            if (PH & 8) { PHASE_ENV(); pg8::Gemm g{(const u16*)(ws + WS_H), (const u16*)(ws + WS_W_HIN), NTOK, 5120, DM}; pg8::StaticOrder S; S.init(NTOK, 5120, G, blk);
              EpiProj E{(u16*)(ws + WS_BIG), (const float*)(ws + WS_LB), (const float*)(ws + WS_ROWSS), (const float*)(ws + WS_BIAS), (LAS float*)(L + XCH_OFF)};
              pg8::gemm_phase<EpiProj, pg8::StaticOrder, true, true>(L, g, S, E); }
            GRID_BAR();
            }
            for (int rp4_ = 0; rp4_ < (PROBE == 4 ? 2 : 1); ++rp4_) { if (rp4_) GRID_BAR();
            if (PH & 16) for (int idx = blockIdx.x; idx < 512; idx += gridDim.x) {
                PHASE_ENV(); u16* BIG = (u16*)(ws + WS_BIG); float* SEGKV = (float*)(ws + WS_H); float* SEGD = (float*)(ws + WS_SEGD);
                const int b = idx >> 8, h = (idx >> 5) & 7, dir = (idx >> 4) & 1, seg = idx & 15;
                if ((dir == 0 && seg == 15) || (dir == 1 && seg == 0)) continue;
                gla_pass<0>(L, nullptr, BIG + (dir ? 2 : 1) * PL, BIG + 3 * PL, nullptr, nullptr, nullptr, NCTX + b * 4096 + seg * 256, h, dir, nullptr, SEGKV + (size_t)idx * 16384, SEGD + (size_t)idx * 128, nullptr, tid);
            }
            }
            GRID_BAR();
            if (PH & 32) for (int w = blockIdx.x; w < 256; w += gridDim.x) {
                PHASE_ENV(); float* SEGKV = (float*)(ws + WS_H); const float* SEGD = (const float*)(ws + WS_SEGD);
                const int chain = w >> 3, part = w & 7, e4 = (part * 512 + tid) * 4, d = e4 >> 7;
                const int dir = chain & 1, bh = chain >> 1;
                const int b = bh >> 3, h = bh & 7;
                f32x4 S = *(const f32x4*)(IN(I_STATE) + ((size_t)((b * 2 + dir) * 8 + h)) * 16384 + e4);
                f32x4 kv[15]; float dd[15];
#pragma unroll
                for (int k = 0; k < 15; ++k) { const int seg = dir ? 15 - k : k; kv[k] = *(const f32x4*)(SEGKV + ((size_t)chain * 16 + seg) * 16384 + e4); dd[k] = SEGD[((size_t)chain * 16 + seg) * 128 + d]; }
#pragma unroll
                for (int k = 0; k < 16; ++k) { const int seg = dir ? 15 - k : k; *(f32x4*)(SEGKV + ((size_t)chain * 16 + seg) * 16384 + e4) = S; if (k < 15) S = S * dd[k < 15 ? k : 0] + kv[k < 15 ? k : 0]; }
            }
            GRID_BAR();
            if (PH & 64) for (int it = blockIdx.x; it < 512; it += gridDim.x) {
                PHASE_ENV(); u16* BIG = (u16*)(ws + WS_BIG); const float* SEGKV = (const float*)(ws + WS_H);
                int row0, h; const float *sif = nullptr, *sib = nullptr; float *sof = nullptr, *sob = nullptr;
                if (it < 256) { const int b = it >> 3; h = it & 7; row0 = b * 256;
                    sof = out + (size_t)NTOK * DM + ((size_t)((b * 2 + 0) * 8 + h)) * 16384; sob = out + (size_t)NTOK * DM + ((size_t)((b * 2 + 1) * 8 + h)) * 16384; }
                else { const int idx = it - 256, b = idx >> 7, seg = idx & 15; h = (idx >> 4) & 7; row0 = NCTX + b * 4096 + seg * 256;
                    sif = SEGKV + ((size_t)(((b * 8 + h) * 2 + 0) * 16 + seg)) * 16384; sib = SEGKV + ((size_t)(((b * 8 + h) * 2 + 1) * 16 + seg)) * 16384; }
                gla_pass<1>(L, BIG, BIG + PL, BIG + 3 * PL, BIG + PL, nullptr, nullptr, row0, h, 0, sif, sof, nullptr, nullptr, tid);
                gla_pass<2>(L, BIG, BIG + 2 * PL, BIG + 3 * PL, BIG + PL, BIG + 4 * PL, BIG, row0, h, 1, sib, sob, nullptr, IN(I_HGN), tid);
            }
            GRID_BAR();
#if PROBE == 1
            {
    if (PH & 4) { PHASE_ENV(); float* rowss = (float*)(ws + WS_ROWSS); float* bias = (float*)(ws + WS_BIAS);
        premod_rows(IN(I_XP), IN(I_XS), IN(I_NMIX), mods + 1 * 1024, (u16*)(ws + WS_H), rowss, gw, NGW, lane);
        for (int r = gw; r < 5120 + 5632 + 3072 + 5632; r += NGW) {
            if (r < 5120) bias_row((const u16*)(ws + WS_W_HIN), r, mods + 0 * 1024, bias, lane);
            else if (r < 5120 + 5632) bias_row((const u16*)(ws + WS_W_UP0), r - 5120, mods + 3 * 1024, bias + BIAS_STRIDE, lane);
            else if (r < 5120 + 5632 + 3072) bias_row((const u16*)(ws + WS_W_SIN), r - 5120 - 5632, mods + 3 * NMODC + 0 * 1024, bias + 2 * BIAS_STRIDE, lane);
            else bias_row((const u16*)(ws + WS_W_UP1), r - 5120 - 5632 - 3072, mods + 3 * NMODC + 3 * 1024, bias + 3 * BIAS_STRIDE, lane);
        }
    }
    GRID_BAR();

            for (int rp2_ = 0; rp2_ < (PROBE == 2 ? 2 : 1); ++rp2_) {
            if (PH & 8) { PHASE_ENV(); pg8::Gemm g{(const u16*)(ws + WS_H), (const u16*)(ws + WS_W_HIN), NTOK, 5120, DM}; pg8::StaticOrder S; S.init(NTOK, 5120, G, blk);
              EpiProj E{(u16*)(ws + WS_BIG), (const float*)(ws + WS_LB), (const float*)(ws + WS_ROWSS), (const float*)(ws + WS_BIAS), (LAS float*)(L + XCH_OFF)};
              pg8::gemm_phase<EpiProj, pg8::StaticOrder, true, true>(L, g, S, E); }
            GRID_BAR();
            }
            for (int rp4_ = 0; rp4_ < (PROBE == 4 ? 2 : 1); ++rp4_) { if (rp4_) GRID_BAR();
            if (PH & 16) for (int idx = blockIdx.x; idx < 512; idx += gridDim.x) {
                PHASE_ENV(); u16* BIG = (u16*)(ws + WS_BIG); float* SEGKV = (float*)(ws + WS_H); float* SEGD = (float*)(ws + WS_SEGD);
                const int b = idx >> 8, h = (idx >> 5) & 7, dir = (idx >> 4) & 1, seg = idx & 15;
                if ((dir == 0 && seg == 15) || (dir == 1 && seg == 0)) continue;
                gla_pass<0>(L, nullptr, BIG + (dir ? 2 : 1) * PL, BIG + 3 * PL, nullptr, nullptr, nullptr, NCTX + b * 4096 + seg * 256, h, dir, nullptr, SEGKV + (size_t)idx * 16384, SEGD + (size_t)idx * 128, nullptr, tid);
            }
            }
            GRID_BAR();
            if (PH & 32) for (int w = blockIdx.x; w < 256; w += gridDim.x) {
                PHASE_ENV(); float* SEGKV = (float*)(ws + WS_H); const float* SEGD = (const float*)(ws + WS_SEGD);
                const int chain = w >> 3, part = w & 7, e4 = (part * 512 + tid) * 4, d = e4 >> 7;
                const int dir = chain & 1, bh = chain >> 1;
                const int b = bh >> 3, h = bh & 7;
                f32x4 S = *(const f32x4*)(IN(I_STATE) + ((size_t)((b * 2 + dir) * 8 + h)) * 16384 + e4);
                f32x4 kv[15]; float dd[15];
#pragma unroll
                for (int k = 0; k < 15; ++k) { const int seg = dir ? 15 - k : k; kv[k] = *(const f32x4*)(SEGKV + ((size_t)chain * 16 + seg) * 16384 + e4); dd[k] = SEGD[((size_t)chain * 16 + seg) * 128 + d]; }
#pragma unroll
                for (int k = 0; k < 16; ++k) { const int seg = dir ? 15 - k : k; *(f32x4*)(SEGKV + ((size_t)chain * 16 + seg) * 16384 + e4) = S; if (k < 15) S = S * dd[k < 15 ? k : 0] + kv[k < 15 ? k : 0]; }
            }
            GRID_BAR();
            if (PH & 64) for (int it = blockIdx.x; it < 512; it += gridDim.x) {
                PHASE_ENV(); u16* BIG = (u16*)(ws + WS_BIG); const float* SEGKV = (const float*)(ws + WS_H);
                int row0, h; const float *sif = nullptr, *sib = nullptr; float *sof = nullptr, *sob = nullptr;
                if (it < 256) { const int b = it >> 3; h = it & 7; row0 = b * 256;
                    sof = out + (size_t)NTOK * DM + ((size_t)((b * 2 + 0) * 8 + h)) * 16384; sob = out + (size_t)NTOK * DM + ((size_t)((b * 2 + 1) * 8 + h)) * 16384; }
                else { const int idx = it - 256, b = idx >> 7, seg = idx & 15; h = (idx >> 4) & 7; row0 = NCTX + b * 4096 + seg * 256;
                    sif = SEGKV + ((size_t)(((b * 8 + h) * 2 + 0) * 16 + seg)) * 16384; sib = SEGKV + ((size_t)(((b * 8 + h) * 2 + 1) * 16 + seg)) * 16384; }
                gla_pass<1>(L, BIG, BIG + PL, BIG + 3 * PL, BIG + PL, nullptr, nullptr, row0, h, 0, sif, sof, nullptr, nullptr, tid);
                gla_pass<2>(L, BIG, BIG + 2 * PL, BIG + 3 * PL, BIG + PL, BIG + 4 * PL, BIG, row0, h, 1, sib, sob, nullptr, IN(I_HGN), tid);
            }
            GRID_BAR();
            }
#endif
            if (PH & 128) { PHASE_ENV(); pg8::Gemm g{(const u16*)(ws + WS_BIG), (const u16*)(ws + WS_W_HOUT), NTOK, DM, DM}; pg8::StaticOrder S; S.init(NTOK, DM, G, blk);
              EpiRes<1> E{IN(I_XP), IN(I_XS), out, mods + 2 * 1024, (u16*)(ws + WS_H), IN(I_NFFN), mods + 4 * 1024, (float*)(ws + WS_ROWSS) + 1 * RSS_STRIDE, (LAS float*)(L + XCH_OFF)};
              pg8::gemm_phase<EpiRes<1>, pg8::StaticOrder, true, true>(L, g, S, E); }
        } else {
            if (PH & 256) { PHASE_ENV(); u16* BIG = (u16*)(ws + WS_BIG); pg8::Gemm g{(const u16*)(ws + WS_H), (const u16*)(ws + WS_W_SIN), NTOK, 3072, DM}; pg8::StaticOrder S; S.init(NTOK, 3072, G, blk);
              EpiSconvIn E{BIG, BIG + PL, (const float*)(ws + WS_ROWSS) + 2 * RSS_STRIDE, (const float*)(ws + WS_BIAS) + 2 * BIAS_STRIDE, (LAS float*)(L + XCH_OFF)};
              pg8::gemm_phase<EpiSconvIn, pg8::StaticOrder, true, true>(L, g, S, E); }
            GRID_BAR();
            if (PH & 512) { PHASE_ENV(); u16* BIG = (u16*)(ws + WS_BIG); sconv_rows(BIG, BIG + PL, IN(I_SCW), IN(I_SCB), BIG + 2 * PL, blk * NWAVES * 64 + tid, G * NWAVES * 64); }
            GRID_BAR();
            if (PH & 1024) { PHASE_ENV(); pg8::Gemm g{(const u16*)(ws + WS_BIG) + 2 * PL, (const u16*)(ws + WS_W_SOUT), NTOK, DM, DM}; pg8::StaticOrder S; S.init(NTOK, DM, G, blk);
              EpiRes<1> E{out, out + (size_t)NCTX * DM, out, mods + 3 * NMODC + 2 * 1024, (u16*)(ws + WS_H), IN(I_NFFN) + DM, mods + 3 * NMODC + 4 * 1024, (float*)(ws + WS_ROWSS) + 3 * RSS_STRIDE, (LAS float*)(L + XCH_OFF)};
              pg8::gemm_phase<EpiRes<1>, pg8::StaticOrder, true, true>(L, g, S, E); }
        }
        GRID_BAR();
        if (PH & 4096) { PHASE_ENV(); pg8::Gemm g{(const u16*)(ws + WS_H), (const u16*)(ws + (layer ? WS_W_UP1 : WS_W_UP0)), NTOK, 2 * DFF, DM}; pg8::StaticOrder S; S.init(NTOK, 2 * DFF, G, blk);
          EpiFfnUp E{(u16*)(ws + WS_BIG), IN(I_FCW) + (size_t)layer * 3 * DFF, IN(I_FCB) + (size_t)layer * DFF, (LAS float*)(L + XCH_OFF), (const float*)(ws + WS_ROWSS) + (layer ? 3 : 1) * RSS_STRIDE, (const float*)(ws + WS_BIAS) + (layer ? 3 : 1) * BIAS_STRIDE};
          pg8::gemm_phase<EpiFfnUp, pg8::StaticOrder, true, true>(L, g, S, E); }
        GRID_BAR();
        if (PH & 8192) { PHASE_ENV(); pg8::Gemm g{(const u16*)(ws + WS_BIG), (const u16*)(ws + (layer ? WS_W_DN1 : WS_W_DN0)), NTOK, DM, DFF}; pg8::StaticOrder S; S.init(NTOK, DM, G, blk);
          if (layer == 0) { EpiRes<1> E{out, out + (size_t)NCTX * DM, out, mods + 5 * 1024, (u16*)(ws + WS_H), IN(I_NMIX) + DM, mods + 3 * NMODC + 1 * 1024, (float*)(ws + WS_ROWSS) + 2 * RSS_STRIDE, (LAS float*)(L + XCH_OFF)};
            pg8::gemm_phase<EpiRes<1>, pg8::StaticOrder, true, true>(L, g, S, E); }
          else { EpiRes<2> E{out, out + (size_t)NCTX * DM, out, mods + 3 * NMODC + 5 * 1024, nullptr, nullptr, nullptr, (float*)(ws + WS_ROWSS) + 4 * RSS_STRIDE, (LAS float*)(L + XCH_OFF)};
            pg8::gemm_phase<EpiRes<2>, pg8::StaticOrder, true, true>(L, g, S, E); } }
        GRID_BAR();
    }
    if (PH & 16384) { PHASE_ENV(); final_norm_rows(out, IN(I_FNW), (const float*)(ws + WS_ROWSS) + 4 * RSS_STRIDE, gw, NGW, lane); }
}

extern "C" void kernel_launch(void* const* d_in, const int* in_sizes, int n_in, void* d_out, int out_size, void* d_ws, size_t ws_size, hipStream_t stream) {
    static int grid = 0;
    if (grid == 0) {
        if (n_in != 22 || ws_size < WS_END) { fprintf(stderr, "kernel_launch: unexpected inputs (n_in %d, ws %zu)\n", n_in, ws_size); grid = -1; return; }
        int dev = 0, cus = 0, per_cu = 0;
        if (hipGetDevice(&dev) != hipSuccess || hipDeviceGetAttribute(&cus, hipDeviceAttributeMultiprocessorCount, dev) != hipSuccess) { grid = -1; return; }
        if (hipFuncSetAttribute((const void*)hgrn_dit_fwd, hipFuncAttributeMaxDynamicSharedMemorySize, LDS_BYTES) != hipSuccess) { fprintf(stderr, "kernel_launch: hipFuncSetAttribute failed\n"); grid = -1; return; }
        if (hipOccupancyMaxActiveBlocksPerMultiprocessor(&per_cu, (const void*)hgrn_dit_fwd, NWAVES * 64, LDS_BYTES) != hipSuccess || per_cu < 1) { fprintf(stderr, "kernel_launch: occupancy query says %d\n", per_cu); (void)hipGetLastError(); grid = -1; return; }
        grid = cus;
    }
    if (grid < 0) return;
    (void)hipMemsetAsync((char*)d_ws + WS_CTL, 0, CTL_ZERO_BYTES, stream);
    Args a{};
    for (int i = 0; i < 22; ++i) a.in[i] = (const float*)d_in[i];
    a.out = (float*)d_out; a.ws = (unsigned char*)d_ws;
    void* kargs[] = {&a};
    hipError_t e = hipLaunchCooperativeKernel((const void*)hgrn_dit_fwd, dim3(grid), dim3(NWAVES * 64), kargs, LDS_BYTES, stream);
    if (e != hipSuccess) fprintf(stderr, "kernel_launch: cooperative launch failed: %s (grid %d)\n", hipGetErrorString(e), grid);
}
```

```cpp
#include <hip/hip_runtime.h>
#include <cstdio>
#include <cstdint>
typedef float f32x2 __attribute__((ext_vector_type(2)));
namespace pg8 {
#define PG8_LAS __attribute__((address_space(3)))
typedef unsigned short bf16_t;
typedef short bf16x8 __attribute__((ext_vector_type(8)));
typedef float f32x4 __attribute__((ext_vector_type(4)));
typedef unsigned u32x4 __attribute__((ext_vector_type(4)));
constexpr int BM = 256, BK = 64, HALF = 128, HTB = HALF * BK * 2  , STAGE_BYTES = 8 * HTB, NXCD = 8, WGM = 8;

__host__ __device__ __forceinline__ int lds_byte(int r, int c) { const int st = (r >> 4) * 2 + (c >> 5), rr = r & 15, cc = c & 31, ob = rr * 64 + cc * 2; return st * 1024 + (ob ^ (((ob >> 9) & 1) << 5)); }
__host__ __device__ __forceinline__ void stage_rc(int b, int& R, int& C) { const int st = b / 1024, sb = b % 1024, swz = sb ^ (((sb >> 9) & 1) << 5); R = (st >> 1) * 16 + swz / 64; C = (st & 1) * 32 + (swz % 64) / 2; }
__host__ __device__ __forceinline__ int perm32(int rho) { const int n = rho >> 4, i = rho & 15; return 8 * (i >> 2) + 4 * n + (i & 3); }

struct Unit { int pm, pn; };
struct Gemm { const bf16_t* A; const bf16_t* Bt; int M, N, K; };

struct StaticOrder {
    int nM, nN, nwg, G, c;
    __host__ __device__ void init(int M, int N, int G_, int c_) { nM = M / BM; nN = N / BM; nwg = nM * nN; G = G_; c = c_; }
    __host__ __device__ bool next(int i, Unit& u) const {
        const long L = (long)i * G + c; if (L >= nwg) return false;
        int wgid = (int)L; { const int q = nwg / NXCD, r = nwg % NXCD, xcd = wgid % NXCD, off = wgid / NXCD; wgid = (xcd < r ? xcd * (q + 1) : r * (q + 1) + (xcd - r) * q) + off; }
        const int nig = WGM * nN, gid = wgid / nig, fm = gid * WGM, gsz = (nM - fm) < WGM ? (nM - fm) : WGM;
        u.pm = fm + ((wgid % nig) % gsz); u.pn = (wgid % nig) / gsz; return true;
    }
    __device__ __forceinline__ void a_ready(const Unit&) const {}
    __device__ __forceinline__ void done(const Unit&) const {}
};

template <class Epi, class Sched, bool ALIGN_EPI = false, bool SP2 = false>
__device__ __forceinline__ void gemm_phase(PG8_LAS unsigned char* lds, const Gemm g, const Sched& S, const Epi& E) {
    int tid_ = threadIdx.x; asm volatile("" : "+v"(tid_));
    const int tid = tid_, wid = __builtin_amdgcn_readfirstlane(tid >> 6), lane = tid & 63, wr = wid >> 2, wc = wid & 3, fr = lane & 15, fq = lane >> 4;
    const int K = g.K, nt = K / BK;
    unsigned voffA[2], voffB[2];
#pragma unroll
    for (int i = 0; i < 2; ++i) { int R, C; stage_rc(tid * 16 + i * 8192, R, C); const int Rb = Epi::PERM ? ((R & ~31) + perm32(R & 31)) : R;
        voffA[i] = (unsigned)(R * K + C) * 2u; voffB[i] = (unsigned)(Rb * K + C) * 2u; }
    const size_t kstep = (size_t)(BK * 2);
    const size_t hstep = (size_t)HALF * K * 2;
    const size_t tstep = 2 * hstep;
    const unsigned ldsw = (unsigned)wid * 1024u;
    const int aoff = lds_byte(wr * 64 + fr, fq * 8), boff = lds_byte(wc * 32 + fr, fq * 8);
#define PG8_SA(b, h) (((b) * 2 + (h)) * HTB)
#define PG8_SB(b, h) ((4 + (b) * 2 + (h)) * HTB)
#define PG8_STAGE(bufoff, gbase, voff) do { _Pragma("unroll") for (int _i = 0; _i < 2; ++_i) \
        __builtin_amdgcn_global_load_lds((const unsigned*)((const char*)(gbase) + (voff)[_i]), (PG8_LAS unsigned*)(lds + (bufoff) + ldsw + _i * 8192), 16, 0, 0); } while (0)
#define PG8_LDA(dst, b, h) do { _Pragma("unroll") for (int m = 0; m < 4; ++m) _Pragma("unroll") for (int k = 0; k < 2; ++k) dst[m][k] = *(const PG8_LAS bf16x8*)(lds + PG8_SA(b, h) + aoff + m * 2048 + k * 1024); } while (0)
#define PG8_LDB(dst, b, h) do { _Pragma("unroll") for (int n = 0; n < 2; ++n) _Pragma("unroll") for (int k = 0; k < 2; ++k) dst[n][k] = *(const PG8_LAS bf16x8*)(lds + PG8_SB(b, h) + boff + n * 2048 + k * 1024); } while (0)
#define PG8_MMA(ai, bj, At, Bt) do { __builtin_amdgcn_s_setprio(1); _Pragma("unroll") for (int m = 0; m < 4; ++m) _Pragma("unroll") for (int n = 0; n < 2; ++n) _Pragma("unroll") for (int k = 0; k < 2; ++k) \
        acc[ai][bj][m][n] = __builtin_amdgcn_mfma_f32_16x16x32_bf16(Bt[n][k], At[m][k], acc[ai][bj][m][n], 0, 0, 0); __builtin_amdgcn_s_setprio(0); } while (0)
#define PG8_WAIT_V(n) asm volatile("s_waitcnt vmcnt(" #n ")" ::: "memory")
#define PG8_WAIT_L(n) asm volatile("s_waitcnt lgkmcnt(" #n ")" ::: "memory")
#define PG8_BAR __builtin_amdgcn_s_barrier()
#define PG8_SCHED __builtin_amdgcn_sched_barrier(0)
    Unit cur, nxt; int ui = 0;
    if (!S.next(0, cur)) return;
    f32x4 acc[2][2][4][2];
#pragma unroll
    for (int a = 0; a < 2; ++a)
#pragma unroll
        for (int b = 0; b < 2; ++b)
#pragma unroll
            for (int m = 0; m < 4; ++m)
#pragma unroll
                for (int n = 0; n < 2; ++n) acc[a][b][m][n] = (f32x4){0.f, 0.f, 0.f, 0.f};
    bf16x8 At[4][2], B0[2][2], B1[2][2];
    const char* cA = (const char*)g.A + (size_t)cur.pm * tstep; const char* cB = (const char*)g.Bt + (size_t)cur.pn * tstep;
    S.a_ready(cur);
    if constexpr (SP2) {
        PG8_STAGE(PG8_SB(0, 0), cB, voffB); PG8_STAGE(PG8_SB(0, 1), cB + hstep, voffB); PG8_STAGE(PG8_SA(0, 0), cA, voffA); PG8_STAGE(PG8_SA(0, 1), cA + hstep, voffA);
        if (wr == 1) PG8_BAR;
        PG8_WAIT_V(2); PG8_BAR;
        PG8_STAGE(PG8_SB(1, 0), cB + kstep, voffB); PG8_STAGE(PG8_SA(1, 0), cA + kstep, voffA); PG8_STAGE(PG8_SB(1, 1), cB + hstep + kstep, voffB);
        PG8_WAIT_V(6); PG8_BAR;
    } else {
        PG8_STAGE(PG8_SB(0, 0), cB, voffB); PG8_STAGE(PG8_SA(0, 0), cA, voffA); PG8_STAGE(PG8_SB(0, 1), cB + hstep, voffB); PG8_STAGE(PG8_SA(0, 1), cA + hstep, voffA);
        if (wr == 1) PG8_BAR;
        PG8_WAIT_V(4); PG8_BAR;
        PG8_STAGE(PG8_SB(1, 0), cB + kstep, voffB); PG8_STAGE(PG8_SA(1, 0), cA + kstep, voffA); PG8_STAGE(PG8_SB(1, 1), cB + hstep + kstep, voffB);
        PG8_WAIT_V(6); PG8_BAR;
    }
    for (;;) {
        const bool has_next = S.next(ui + 1, nxt);
        const char* nA = has_next ? (const char*)g.A + (size_t)nxt.pm * tstep : cA; const char* nB = has_next ? (const char*)g.Bt + (size_t)nxt.pn * tstep : cB;
        for (int t = 0; t < nt; t += 2) {
            const bool last = (t == nt - 2);
            const char* a1 = cA + (size_t)(t + 1) * kstep;
            const char* a2 = last ? nA : cA + (size_t)(t + 2) * kstep; const char* b2 = last ? nB : cB + (size_t)(t + 2) * kstep;
            const char* a3 = a2 + kstep; const char* b3 = b2 + kstep;
            if (last && has_next) S.a_ready(nxt);
            if constexpr (SP2) {
            PG8_LDB(B0, 0, 0); PG8_LDB(B1, 0, 1); PG8_SCHED; PG8_LDA(At, 0, 0); PG8_STAGE(PG8_SA(1, 1), a1 + hstep, voffA);
            PG8_WAIT_V(8); PG8_WAIT_L(0); PG8_BAR; PG8_MMA(0, 0, At, B0); PG8_MMA(0, 1, At, B1); PG8_BAR; PG8_SCHED;
            PG8_LDA(At, 0, 1); PG8_STAGE(PG8_SB(0, 0), b2, voffB); PG8_STAGE(PG8_SB(0, 1), b2 + hstep, voffB); PG8_STAGE(PG8_SA(0, 0), a2, voffA);
            PG8_WAIT_V(8); PG8_WAIT_L(0); PG8_BAR; PG8_MMA(1, 0, At, B0); PG8_MMA(1, 1, At, B1); PG8_BAR; PG8_SCHED;
            PG8_LDB(B0, 1, 0); PG8_LDB(B1, 1, 1); PG8_SCHED; PG8_LDA(At, 1, 0); PG8_STAGE(PG8_SA(0, 1), a2 + hstep, voffA);
            PG8_WAIT_V(8); PG8_WAIT_L(0); PG8_BAR; PG8_MMA(0, 0, At, B0); PG8_MMA(0, 1, At, B1); PG8_BAR; PG8_SCHED;
            PG8_LDA(At, 1, 1); PG8_STAGE(PG8_SB(1, 0), b3, voffB); PG8_STAGE(PG8_SB(1, 1), b3 + hstep, voffB); PG8_STAGE(PG8_SA(1, 0), a3, voffA);
            PG8_WAIT_V(8); PG8_WAIT_L(0); PG8_BAR; PG8_MMA(1, 0, At, B0); PG8_MMA(1, 1, At, B1); PG8_BAR; PG8_SCHED;
            } else {
            PG8_LDB(B0, 0, 0); PG8_SCHED; PG8_LDA(At, 0, 0); PG8_STAGE(PG8_SA(1, 1), a1 + hstep, voffA);
            PG8_WAIT_L(8); PG8_BAR; PG8_WAIT_L(0); PG8_MMA(0, 0, At, B0); PG8_BAR; PG8_SCHED;
            PG8_LDB(B1, 0, 1); PG8_STAGE(PG8_SB(0, 0), b2, voffB);
            PG8_BAR; PG8_WAIT_L(0); PG8_MMA(0, 1, At, B1); PG8_BAR;
            PG8_LDA(At, 0, 1); PG8_STAGE(PG8_SA(0, 0), a2, voffA);
            PG8_BAR; PG8_WAIT_L(0); PG8_MMA(1, 0, At, B0); PG8_BAR; PG8_SCHED;
            PG8_STAGE(PG8_SB(0, 1), b2 + hstep, voffB);
            PG8_WAIT_V(6); PG8_BAR; PG8_MMA(1, 1, At, B1); PG8_BAR;
            PG8_LDB(B0, 1, 0); PG8_SCHED; PG8_LDA(At, 1, 0); PG8_STAGE(PG8_SA(0, 1), a2 + hstep, voffA);
            PG8_WAIT_L(8); PG8_BAR; PG8_WAIT_L(0); PG8_MMA(0, 0, At, B0); PG8_BAR; PG8_SCHED;
            PG8_LDB(B1, 1, 1); PG8_STAGE(PG8_SB(1, 0), b3, voffB);
            PG8_BAR; PG8_WAIT_L(0); PG8_MMA(0, 1, At, B1); PG8_BAR;
            PG8_LDA(At, 1, 1); PG8_STAGE(PG8_SA(1, 0), a3, voffA);
            PG8_BAR; PG8_WAIT_L(0); PG8_MMA(1, 0, At, B0); PG8_BAR; PG8_SCHED;
            PG8_STAGE(PG8_SB(1, 1), b3 + hstep, voffB);
            PG8_WAIT_V(6); PG8_BAR; PG8_MMA(1, 1, At, B1); PG8_BAR;
            }
        }
        if constexpr (ALIGN_EPI) { if (wr == 0) PG8_BAR; }
        if constexpr (!Epi::AFTER_DRAIN) { E(acc, cur, wr, wc, fr, fq); S.done(cur); }
        if (!has_next) break;
#pragma unroll
        for (int a = 0; a < 2; ++a)
#pragma unroll
            for (int b = 0; b < 2; ++b)
#pragma unroll
                for (int m = 0; m < 4; ++m)
#pragma unroll
                    for (int n = 0; n < 2; ++n) acc[a][b][m][n] = (f32x4){0.f, 0.f, 0.f, 0.f};
        cur = nxt; cA = nA; cB = nB; ++ui;
        if constexpr (ALIGN_EPI) { if (wr == 1) PG8_BAR; }
    }
    PG8_WAIT_V(0);
    if constexpr (!ALIGN_EPI) { if (wr == 0) PG8_BAR; }
    PG8_BAR;
    if constexpr (Epi::AFTER_DRAIN) { E.fused(acc, cur, wr, wc, fr, fq, lds, wid, lane); S.done(cur); }
#undef PG8_SA
#undef PG8_SB
#undef PG8_STAGE
#undef PG8_LDA
#undef PG8_LDB
#undef PG8_MMA
#undef PG8_WAIT_V
#undef PG8_WAIT_L
#undef PG8_BAR
#undef PG8_SCHED
}
}

constexpr int NWAVES = 8;
constexpr int DM = 1024, NTOK = 16384, NCTX = 8192, DFF = 2816, NMODC = 6144;
constexpr float EPSN = 1e-6f;
constexpr size_t MiB = 1u << 20;
constexpr size_t PL = (size_t)NTOK * DM;
constexpr size_t WS_CTL = 0, CTL_ZERO_BYTES = 1 * MiB;
constexpr int    CW_BAR = 4096;
constexpr size_t WS_MODS = 64 * 1024;
constexpr size_t WS_LB = 208 * 1024;
constexpr size_t WS_BIAS = 256 * 1024;
constexpr size_t WS_ROWSS = 247 * MiB;
constexpr int BIAS_STRIDE = 3 * 5632, RSS_STRIDE = 4 * NTOK;
constexpr size_t WS_W_HIN = 1 * MiB, WS_W_HOUT = 11 * MiB, WS_W_SIN = 13 * MiB, WS_W_SOUT = 19 * MiB;
constexpr size_t WS_W_UP0 = 21 * MiB, WS_W_UP1 = 32 * MiB, WS_W_DN0 = 43 * MiB, WS_W_DN1 = 43 * MiB + 5767168;
constexpr size_t WS_H = 54 * MiB;
constexpr size_t WS_BIG = 86 * MiB;
constexpr size_t WS_SEGD = 246 * MiB;
constexpr size_t WS_END = 256 * MiB;
static_assert(WS_W_DN1 + 5767168 == WS_H && WS_BIG + 5 * PL * 2 == WS_SEGD, "ws map");
constexpr int RING_BYTES = 131072, XCH_OFF = RING_BYTES, XCH_BYTES = 8192, MISC_OFF = XCH_OFF + XCH_BYTES, LDS_BYTES = 147456;

#define GAS __attribute__((address_space(1)))
#define LAS __attribute__((address_space(3)))
typedef unsigned short u16;
typedef unsigned u32x4 __attribute__((ext_vector_type(4)));
typedef unsigned u32x2 __attribute__((ext_vector_type(2)));
typedef float f32x4 __attribute__((ext_vector_type(4)));
typedef short bf16x8 __attribute__((ext_vector_type(8)));
typedef __bf16 bf16x2_t __attribute__((ext_vector_type(2)));
typedef _Float16 f16x2_t __attribute__((ext_vector_type(2)));
#define LBAR() do { asm volatile("s_waitcnt lgkmcnt(0)" ::: "memory"); __builtin_amdgcn_s_barrier(); asm volatile("" ::: "memory"); } while (0)

__device__ __forceinline__ unsigned pk2(float lo, float hi) { f32x2 v = {lo, hi}; bf16x2_t b = __builtin_convertvector(v, bf16x2_t); return __builtin_bit_cast(unsigned, b); }
__device__ __forceinline__ unsigned pkh2(float lo, float hi) { f32x2 v = {lo, hi}; f16x2_t b = __builtin_convertvector(v, f16x2_t); return __builtin_bit_cast(unsigned, b); }
__device__ __forceinline__ float bflo(unsigned u) { return __builtin_bit_cast(float, u << 16); }
__device__ __forceinline__ float bfhi(unsigned u) { return __builtin_bit_cast(float, u & 0xffff0000u); }
__device__ __forceinline__ float bf1(u16 u) { return __builtin_bit_cast(float, (unsigned)u << 16); }
__device__ __forceinline__ float hlo(unsigned u) { return (float)__builtin_bit_cast(_Float16, (u16)(u & 0xffffu)); }
__device__ __forceinline__ float hhi(unsigned u) { return (float)__builtin_bit_cast(_Float16, (u16)(u >> 16)); }
__device__ __forceinline__ float frcp(float x) { return __builtin_amdgcn_rcpf(x); }
__device__ __forceinline__ float frsq(float x) { return __builtin_amdgcn_rsqf(x); }
__device__ __forceinline__ float siluf(float x) { return x * frcp(1.f + __expf(-x)); }
template <int CTRL> __device__ __forceinline__ float dppf(float v) { return __builtin_bit_cast(float, __builtin_amdgcn_update_dpp(0, __builtin_bit_cast(int, v), CTRL, 0xF, 0xF, true)); }
__device__ __forceinline__ float row16_sum(float v) { v += dppf<0xB1>(v); v += dppf<0x4E>(v); v += dppf<0x141>(v); v += dppf<0x140>(v); return v; }
__device__ __forceinline__ float wave_sum(float v) {
#pragma unroll
    for (int o = 1; o < 64; o <<= 1) v += __shfl_xor(v, o);
    return v;
}
__device__ __forceinline__ int row_group(int row) { return row < NCTX ? 0 : 1 + ((row - NCTX) >> 12); }

#define XB_TMO      128
#define XB_XCNT(j)  (256  + 64 * (j))
#define XB_XSUB(j)  (1280 + 64 * (j))
#define XB_XGEN(j)  (2304 + 64 * (j))
#define XB_TOP      3328
#define XB_TOPGEN   3392
#define XCD_BAR_WORDS 3456
#define XB_SPIN_CAP (1u << 18)

__device__ __forceinline__ unsigned xb_ld(unsigned* p)              { return __hip_atomic_load(p, __ATOMIC_RELAXED, __HIP_MEMORY_SCOPE_AGENT); }
__device__ __forceinline__ unsigned xb_add(unsigned* p, unsigned v) { return __hip_atomic_fetch_add(p, v, __ATOMIC_RELAXED, __HIP_MEMORY_SCOPE_AGENT); }
__device__ __forceinline__ unsigned xb_xcc_id() { return (unsigned)__builtin_amdgcn_s_getreg((3 << 11) | 20) & 0xFu; }
#define XB_SPIN(cond, bar) do { unsigned _sp = 0; while (cond) { __builtin_amdgcn_s_sleep(1); \
    if ((++_sp & 255u) == 0u) { if (xb_ld(&(bar)[XB_TMO])) break; if (_sp > XB_SPIN_CAP) { atomicAdd(&(bar)[XB_TMO], 1u); break; } } } } while (0)

struct XcdBarrier {
    unsigned* bar; unsigned x;
    volatile LAS unsigned* st;
};

__device__ __forceinline__ XcdBarrier xcd_barrier_post(unsigned* bar, volatile LAS unsigned* st) {
    XcdBarrier b; b.bar = bar; b.x = xb_xcc_id(); b.st = st;
    if (threadIdx.x == 0) (void)xb_add(&bar[XB_XCNT(b.x)], 1u);
    return b;
}
__device__ __forceinline__ void xcd_barrier_complete(unsigned* bar, unsigned x, unsigned& nloc, unsigned& nx) {
    const unsigned G = gridDim.x * gridDim.y * gridDim.z;
    unsigned sum, cnt, mine, sp = 0u;
    for (;;) {
        sum = 0u; cnt = 0u; mine = 0u;
#pragma unroll
        for (unsigned j = 0; j < 16; ++j) { const unsigned c = xb_ld(&bar[XB_XCNT(j)]); sum += c; cnt += (c > 0u) ? 1u : 0u; mine = (j == x) ? c : mine; }
        if (sum == G) break;
        __builtin_amdgcn_s_sleep(1);
        if ((++sp & 255u) == 0u) { if (xb_ld(&bar[XB_TMO])) break; if (sp > XB_SPIN_CAP) { atomicAdd(&bar[XB_TMO], 1u); break; } }
    }
    nloc = mine > 0u ? mine : 1u; nx = cnt > 0u ? cnt : 1u;
}

__device__ __forceinline__ void xcd_barrier(const XcdBarrier& b) {
    asm volatile("s_waitcnt vmcnt(0)" ::: "memory");
    __syncthreads();
    if (threadIdx.x == 0) {
        unsigned* bar = b.bar;
        __builtin_amdgcn_s_waitcnt(0);
        unsigned nloc = b.st[0], nx = b.st[1];
        if (nloc == 0u) { xcd_barrier_complete(bar, b.x, nloc, nx); b.st[0] = nloc; b.st[1] = nx; }
        const unsigned old = xb_add(&bar[XB_XSUB(b.x)], 1u);
        const unsigned gen = old / nloc;
        if (old + 1u == (gen + 1u) * nloc) {
            __builtin_amdgcn_fence(__ATOMIC_RELEASE, "agent");
            asm volatile("s_waitcnt vmcnt(0)" ::: "memory");
            const unsigned og = xb_add(&bar[XB_TOP], 1u);
            const unsigned tg = og / nx;
            if (og + 1u == (tg + 1u) * nx) xb_add(&bar[XB_TOPGEN], 1u);
            else XB_SPIN(xb_ld(&bar[XB_TOPGEN]) == tg, bar);
            __builtin_amdgcn_fence(__ATOMIC_ACQUIRE, "agent");
            xb_add(&bar[XB_XGEN(b.x)], 1u);
            asm volatile("s_waitcnt vmcnt(0)" ::: "memory");
        } else {
            XB_SPIN(xb_ld(&bar[XB_XGEN(b.x)]) == gen, bar);
            __builtin_amdgcn_fence(__ATOMIC_ACQUIRE, "agent");
            asm volatile("s_waitcnt vmcnt(0)" ::: "memory");
        }
    }
    __syncthreads();
}

using pg8::Unit;
__device__ __forceinline__ float rstd4(const float* p) { return frsq(((p[0] + p[NTOK]) + (p[2 * NTOK] + p[3 * NTOK])) * (1.f / DM) + EPSN); }

struct EpiProj {
    static constexpr bool PERM = true, AFTER_DRAIN = false;
    u16* planes; const float* lb; const float* rowss; const float* bias; LAS float* xch;
    __device__ __forceinline__ void operator()(const f32x4 (&acc)[2][2][4][2], const Unit& u, int wr, int wc, int fr_, int fq_) const {
        int fr = fr_, fq = fq_; asm volatile("" : "+v"(fr), "+v"(fq));
        const int plane = u.pn >> 2, colt = (u.pn & 3) * 256;
        const bool isgate = (plane == 1 || plane == 2), issilu = (plane == 0 || plane == 4);
        {
            int t = threadIdx.x; asm volatile("" : "+v"(t));
            if (t < 256) xch[1792 + t] = rstd4(rowss + u.pm * 256 + t);
            else if (t < 320) { const int c4 = (t - 256) * 4; *(LAS f32x4*)(xch + 1024 + c4) = *(const f32x4*)(bias + row_group(u.pm * 256) * 5632 + u.pn * 256 + c4); }
            else if (t < 384) { const int c4 = (t - 320) * 4; *(LAS f32x4*)(xch + 1280 + c4) = *(const f32x4*)(lb + (isgate ? (plane - 1) * 1024 : 0) + colt + c4); }
        }
        LBAR();
        u16* base = planes + (size_t)plane * PL;
        const int row0 = u.pm * 256 + wr * 64 + fr, col0 = colt + wc * 32 + 8 * fq;
        const LAS float* bl = xch + 1024 + wc * 32 + 8 * fq;
        const LAS float* ll = xch + 1280 + wc * 32 + 8 * fq;
        const LAS float* rl = xch + 1792 + wr * 64 + fr;
#pragma unroll
        for (int ai = 0; ai < 2; ++ai)
#pragma unroll
            for (int m = 0; m < 4; ++m) {
                u16* rowp = base + (size_t)(row0 + ai * 128 + m * 16) * DM + col0;
                const float rs = rl[ai * 128 + m * 16];
#pragma unroll
                for (int bj = 0; bj < 2; ++bj) {
                    float x[8];
#pragma unroll
                    for (int n = 0; n < 2; ++n) { const f32x4 bv = *(const LAS f32x4*)(bl + bj * 128 + 4 * n);
#pragma unroll
                        for (int i = 0; i < 4; ++i) x[4 * n + i] = acc[ai][bj][m][n][i] * rs + bv[i]; }
                    u32x4 w;
                    if (isgate) {
                        const f32x4 l0 = *(const LAS f32x4*)(ll + bj * 128), l1 = *(const LAS f32x4*)(ll + bj * 128 + 4);
#pragma unroll
                        for (int e = 0; e < 8; ++e) { const float l = e < 4 ? l0[e & 3] : l1[e & 3]; const float sg = frcp(1.f + __expf(-x[e])); x[e] = __logf(l + (1.f - l) * sg); }
                        w.x = pkh2(x[0], x[1]); w.y = pkh2(x[2], x[3]); w.z = pkh2(x[4], x[5]); w.w = pkh2(x[6], x[7]);
                    } else {
                        if (issilu) {
#pragma unroll
                            for (int e = 0; e < 8; ++e) x[e] = siluf(x[e]);
                        }
                        w.x = pk2(x[0], x[1]); w.y = pk2(x[2], x[3]); w.z = pk2(x[4], x[5]); w.w = pk2(x[6], x[7]);
                    }
                    *(u32x4*)(rowp + bj * 128) = w;
                }
            }
    }
};

template <int NEXT> struct EpiRes {
    static constexpr bool PERM = false, AFTER_DRAIN = false;
    const float* resA; const float* resB; float* out; const float* gate;
    u16* An; const float* nw; const float* scale; float* rowss; LAS float* xch;
    __device__ __forceinline__ void operator()(const f32x4 (&acc)[2][2][4][2], const Unit& u, int wr, int wc, int fr_, int fq_) const {
        int fr = fr_, fq = fq_; asm volatile("" : "+v"(fr), "+v"(fq));
        const int row0 = u.pm * 256 + wr * 64 + fr, col0 = u.pn * 256 + wc * 32 + 4 * fq;
        const int grp = row_group(u.pm * 256);
        const float* gp = gate + grp * NMODC + col0;
        f32x4 gv[2][2], wm[2][2];
#pragma unroll
        for (int bj = 0; bj < 2; ++bj)
#pragma unroll
            for (int n = 0; n < 2; ++n) { gv[bj][n] = *(const f32x4*)(gp + bj * 128 + n * 16);
                if (NEXT == 1) wm[bj][n] = *(const f32x4*)(nw + col0 + bj * 128 + n * 16) * (*(const f32x4*)(scale + grp * NMODC + col0 + bj * 128 + n * 16) + 1.0f); }
#pragma unroll
        for (int ai = 0; ai < 2; ++ai)
#pragma unroll
            for (int m = 0; m < 4; ++m) {
                const int row = row0 + ai * 128 + m * 16;
                const float* rp = (row < NCTX ? resA + (size_t)row * DM : resB + (size_t)(row - NCTX) * DM) + col0;
                float* op = out + (size_t)row * DM + col0;
                float ss = 0.f;
#pragma unroll
                for (int bj = 0; bj < 2; ++bj)
#pragma unroll
                    for (int n = 0; n < 2; ++n) { const f32x4 r = *(const f32x4*)(rp + bj * 128 + n * 16); const f32x4 o = r + gv[bj][n] * acc[ai][bj][m][n]; *(f32x4*)(op + bj * 128 + n * 16) = o;
                        if (NEXT >= 1) ss += (o[0] * o[0] + o[1] * o[1]) + (o[2] * o[2] + o[3] * o[3]);
                        if (NEXT == 1) { const f32x4 a = o * wm[bj][n]; u32x2 p; p.x = pk2(a[0], a[1]); p.y = pk2(a[2], a[3]); *(u32x2*)(An + (size_t)row * DM + col0 + bj * 128 + n * 16) = p; } }
                if (NEXT >= 1) { ss += __shfl_xor(ss, 16); ss += __shfl_xor(ss, 32); if (fq == 0) xch[wc * 256 + ai * 128 + wr * 64 + m * 16 + fr] = ss; }
            }
        if (NEXT >= 1) {
            LBAR();
            int t = threadIdx.x; asm volatile("" : "+v"(t));
            if (t < 256) rowss[(size_t)u.pn * NTOK + u.pm * 256 + t] = (xch[t] + xch[256 + t]) + (xch[512 + t] + xch[768 + t]);
        }
    }
};

struct EpiFfnUp {
    static constexpr bool PERM = true, AFTER_DRAIN = false;
    u16* act; const float* cw; const float* cb; LAS float* xch; const float* rowss; const float* bias;
    __device__ __forceinline__ void operator()(const f32x4 (&acc)[2][2][4][2], const Unit& u, int wr, int wc, int fr_, int fq_) const {
        int fr = fr_, fq = fq_; asm volatile("" : "+v"(fr), "+v"(fq));
        const int lane = (fq << 4) | fr;
        const bool ctx = (u.pm * 256) < NCTX;
        const int colq = wc * 32 + 8 * fq;
        const int gcol = u.pn * 128 + colq;
        {
            int t = threadIdx.x; asm volatile("" : "+v"(t));
            if (t < 256) xch[1792 + t] = rstd4(rowss + u.pm * 256 + t);
            else if (t < 448) { const int q = t - 256, v = q >> 5, c4 = (q & 31) * 4; const float* bt = bias + row_group(u.pm * 256) * 5632 + u.pn * 256;
                const f32x4 x = v < 3 ? *(const f32x4*)(cw + v * DFF + u.pn * 128 + c4) : v == 3 ? *(const f32x4*)(cb + u.pn * 128 + c4) : *(const f32x4*)(bt + (v - 4) * 128 + c4);
                *(LAS f32x4*)(xch + 1024 + v * 128 + c4) = x; }
        }
        if (fr == 0 || fr == 15) {
#pragma unroll
            for (int ai = 0; ai < 2; ++ai) {
                LAS float* p = xch + (((wr * 4 + wc) * 2 + ai) * 2 + (fr == 0 ? 0 : 1)) * 32 + 8 * fq;
                *(LAS f32x4*)p = fr == 0 ? acc[ai][0][0][0] : acc[ai][0][3][0]; *(LAS f32x4*)(p + 4) = fr == 0 ? acc[ai][0][0][1] : acc[ai][0][3][1];
            }
        }
        LBAR();
        const int src_up = (lane & 48) | ((fr + 15) & 15), src_dn = (lane & 48) | ((fr + 1) & 15);
        const LAS float* cwl = xch + 1024 + colq;
        const LAS float* rl = xch + 1792;
#pragma unroll
        for (int ai = 0; ai < 2; ++ai) {
            const bool has_u = ctx && (wr == 1 || ai == 1);
            const int uai = wr == 1 ? ai : 0;
            const bool has_d = ctx && (wr == 0 || ai == 0);
            const int dai = wr == 0 ? ai : 1;
            const LAS float* pu = xch + ((((1 - wr) * 4 + wc) * 2 + uai) * 2 + 1) * 32 + 8 * fq;
            const LAS float* pd = xch + ((((1 - wr) * 4 + wc) * 2 + dai) * 2 + 0) * 32 + 8 * fq;
            const int rbase = ai * 128 + wr * 64;
            const float rsu = has_u ? rl[rbase - 1] : 0.f, rsd = has_d ? rl[rbase + 64] : 0.f;
            float rs[4];
#pragma unroll
            for (int m = 0; m < 4; ++m) rs[m] = rl[rbase + m * 16 + fr];
#define FU_A(m, n, i) (acc[ai][0][m][n][i] * rs[m] + ba[i])
#pragma unroll
            for (int m = 0; m < 4; ++m) {
                unsigned wv[4];
#pragma unroll
                for (int n = 0; n < 2; ++n) {
                    const f32x4 ba = *(const LAS f32x4*)(cwl + 4 * 128 + 4 * n), bgq = *(const LAS f32x4*)(cwl + 5 * 128 + 4 * n);
                    const f32x4 w0q = *(const LAS f32x4*)(cwl + 4 * n), w1q = *(const LAS f32x4*)(cwl + 128 + 4 * n), w2q = *(const LAS f32x4*)(cwl + 256 + 4 * n), bbq = *(const LAS f32x4*)(cwl + 384 + 4 * n);
                    float o[4];
#pragma unroll
                    for (int i = 0; i < 4; ++i) {
                        const float a = FU_A(m, n, i);
                        const float tu = (m > 0 && fr == 15) ? FU_A((m > 0 ? m - 1 : 0), n, i) : a;
                        const float td = (m < 3 && fr == 0) ? FU_A((m < 3 ? m + 1 : 3), n, i) : a;
                        float up = __shfl(tu, src_up), dn = __shfl(td, src_dn);
                        if (m == 0) { const float x = has_u ? pu[4 * n + i] * rsu + ba[i] : 0.f; if (fr == 0) up = x; }
                        if (m == 3) { const float x = has_d ? pd[4 * n + i] * rsd + ba[i] : 0.f; if (fr == 15) dn = x; }
                        const float cv = w0q[i] * up + w1q[i] * a + w2q[i] * dn + bbq[i];
                        o[i] = siluf(cv) * (acc[ai][1][m][n][i] * rs[m] + bgq[i]);
                    }
                    wv[2 * n] = pk2(o[0], o[1]); wv[2 * n + 1] = pk2(o[2], o[3]);
                }
                u32x4 w; w.x = wv[0]; w.y = wv[1]; w.z = wv[2]; w.w = wv[3];
                *(u32x4*)(act + (size_t)(u.pm * 256 + ai * 128 + wr * 64 + m * 16 + fr) * DFF + gcol) = w;
            }
#undef FU_A
        }
    }
};

struct EpiSconvIn {
    static constexpr bool PERM = true, AFTER_DRAIN = false;
    u16* cu; u16* gb; const float* rowss; const float* bias; LAS float* xch;
    __device__ __forceinline__ void operator()(const f32x4 (&acc)[2][2][4][2], const Unit& u, int wr, int wc, int fr_, int fq_) const {
        int fr = fr_, fq = fq_; asm volatile("" : "+v"(fr), "+v"(fq));
        {
            int t = threadIdx.x; asm volatile("" : "+v"(t));
            if (t < 256) xch[1792 + t] = rstd4(rowss + u.pm * 256 + t);
            else if (t < 320) { const int c4 = (t - 256) * 4; *(LAS f32x4*)(xch + 1024 + c4) = *(const f32x4*)(bias + row_group(u.pm * 256) * 5632 + u.pn * 256 + c4); }
        }
        LBAR();
        const int row0 = u.pm * 256 + wr * 64 + fr, colq = wc * 32 + 8 * fq;
        const LAS float* bl = xch + 1024 + colq;
        const LAS float* rl = xch + 1792 + wr * 64 + fr;
        const f32x4 b00 = *(const LAS f32x4*)(bl), b01 = *(const LAS f32x4*)(bl + 4), b10 = *(const LAS f32x4*)(bl + 128), b11 = *(const LAS f32x4*)(bl + 132);
#pragma unroll
        for (int ai = 0; ai < 2; ++ai)
#pragma unroll
            for (int m = 0; m < 4; ++m) {
                const size_t ro = (size_t)(row0 + ai * 128 + m * 16) * DM;
                const float rs = rl[ai * 128 + m * 16];
                if (u.pn < 8) {
                    const f32x4 p0 = (acc[ai][0][m][0] * rs + b00) * (acc[ai][1][m][0] * rs + b10), p1 = (acc[ai][0][m][1] * rs + b01) * (acc[ai][1][m][1] * rs + b11);
                    u32x4 w; w.x = pk2(p0[0], p0[1]); w.y = pk2(p0[2], p0[3]); w.z = pk2(p1[0], p1[1]); w.w = pk2(p1[2], p1[3]);
                    *(u32x4*)(cu + ro + u.pn * 128 + colq) = w;
                } else {
#pragma unroll
                    for (int bj = 0; bj < 2; ++bj) { const f32x4 p0 = acc[ai][bj][m][0] * rs + (bj ? b10 : b00), p1 = acc[ai][bj][m][1] * rs + (bj ? b11 : b01);
                        u32x4 w; w.x = pk2(p0[0], p0[1]); w.y = pk2(p0[2], p0[3]); w.z = pk2(p1[0], p1[1]); w.w = pk2(p1[2], p1[3]);
                        *(u32x4*)(gb + ro + (u.pn - 8) * 256 + bj * 128 + colq) = w; }
                }
            }
    }
};

__device__ __forceinline__ void p0_transpose_item(const float* W, int K, int N, u16* WT, int mode, LAS float* scr, int item, int lane) {
    const int nblk = N / 32, kb = item / nblk, nb = item % nblk, k0 = 64 * kb, n0 = 32 * nb;
    int d0 = n0;
    if (mode == 1) { if (n0 < DFF) d0 = (n0 >> 7) * 256 + (n0 & 127); else { const int n1 = n0 - DFF; d0 = (n1 >> 7) * 256 + 128 + (n1 & 127); } }
    else if (mode == 2) { if (n0 < 1024) d0 = 2048 + n0; else if (n0 < 2048) { const int n1 = n0 - 1024; d0 = (n1 >> 7) * 256 + (n1 & 127); } else { const int n1 = n0 - 2048; d0 = (n1 >> 7) * 256 + 128 + (n1 & 127); } }
#pragma unroll 8
    for (int i = 0; i < 32; ++i) { const int kk = 2 * i + (lane >> 5); scr[kk * 33 + (lane & 31)] = W[(size_t)(k0 + kk) * N + n0 + (lane & 31)]; }
    asm volatile("s_waitcnt lgkmcnt(0)" ::: "memory");
    const int c = lane & 7;
#pragma unroll
    for (int j = 0; j < 4; ++j) { const int n = (lane >> 3) + 8 * j; const LAS float* s = scr + (8 * c) * 33 + n;
        u32x4 o; o.x = pk2(s[0 * 33], s[1 * 33]); o.y = pk2(s[2 * 33], s[3 * 33]); o.z = pk2(s[4 * 33], s[5 * 33]); o.w = pk2(s[6 * 33], s[7 * 33]);
        *(u32x4*)(WT + (size_t)(d0 + n) * K + k0 + 8 * c) = o; }
    asm volatile("s_waitcnt lgkmcnt(0)" ::: "memory");
}

__device__ __forceinline__ void premod_rows(const float* xA, const float* xB, const float* nw, const float* scale, u16* H, float* rowss, int gw, int ngw, int lane) {
    for (int row = gw; row < NTOK; row += ngw) {
        const float* xr = (row < NCTX ? xA + (size_t)row * DM : xB + (size_t)(row - NCTX) * DM);
        const float* sg = scale + row_group(row) * NMODC;
        f32x4 v[4]; float ss = 0.f;
#pragma unroll
        for (int j = 0; j < 4; ++j) { v[j] = *(const f32x4*)(xr + 4 * lane + 256 * j); ss += (v[j][0] * v[j][0] + v[j][1] * v[j][1]) + (v[j][2] * v[j][2] + v[j][3] * v[j][3]); }
        ss = wave_sum(ss);
        if (lane < 4) rowss[(size_t)lane * NTOK + row] = lane == 0 ? ss : 0.f;
#pragma unroll
        for (int j = 0; j < 4; ++j) { const int c = 4 * lane + 256 * j;
            const f32x4 w = *(const f32x4*)(nw + c), sc = *(const f32x4*)(sg + c);
            const f32x4 o = v[j] * w * (sc + 1.0f);
            u32x2 p; p.x = pk2(o[0], o[1]); p.y = pk2(o[2], o[3]);
            *(u32x2*)(H + (size_t)row * DM + c) = p; }
    }
}

__device__ __forceinline__ void bias_row(const u16* Wt, int n, const float* shift, float* bias, int lane) {
    const u16* wr = Wt + (size_t)n * DM;
    const u32x4 w0 = *(const u32x4*)(wr + 8 * lane), w1 = *(const u32x4*)(wr + 512 + 8 * lane);
    float wv[16];
#pragma unroll
    for (int q = 0; q < 4; ++q) { wv[2 * q] = bflo(w0[q]); wv[2 * q + 1] = bfhi(w0[q]); wv[8 + 2 * q] = bflo(w1[q]); wv[8 + 2 * q + 1] = bfhi(w1[q]); }
#pragma unroll
    for (int g = 0; g < 3; ++g) {
        const float* sp = shift + g * NMODC;
        float s = 0.f;
#pragma unroll
        for (int q = 0; q < 2; ++q) { const f32x4 a = *(const f32x4*)(sp + 8 * lane + 4 * q), b = *(const f32x4*)(sp + 512 + 8 * lane + 4 * q);
#pragma unroll
            for (int i = 0; i < 4; ++i) s += wv[4 * q + i] * a[i] + wv[8 + 4 * q + i] * b[i]; }
        s = wave_sum(s);
        if (lane == 0) bias[g * 5632 + n] = s;
    }
}

__device__ __forceinline__ void final_norm_rows(float* X, const float* nw, const float* rowss, int gw, int ngw, int lane) {
    for (int row = gw; row < NTOK; row += ngw) {
        float* xr = X + (size_t)row * DM;
        const float rstd = rstd4(rowss + row);
#pragma unroll
        for (int j = 0; j < 4; ++j) { const int c = 4 * lane + 256 * j; const f32x4 w = *(const f32x4*)(nw + c); const f32x4 v = *(const f32x4*)(xr + c); *(f32x4*)(xr + c) = (v * rstd) * w; }
    }
}

__device__ __forceinline__ void mods_item(int mi, const float* c_ctx, const float* c, const float* ada_w, const float* ada_b, float* mods, LAS float* red, int tid) {
    const int wave = tid >> 6, lane = tid & 63;
    const int l = mi / 96, rem = mi % 96, cc = rem >> 2, kqr = rem & 3;
    const float* W = ada_w + (size_t)l * DM * NMODC + 256 * cc + 4 * lane;
    const int kbase = 256 * kqr + 32 * wave;
    f32x4 a0 = {0.f, 0.f, 0.f, 0.f}, a1 = a0, a2 = a0;
#pragma unroll 8
    for (int kk = 0; kk < 32; ++kk) {
        const int k = kbase + kk;
        const f32x4 w = *(const f32x4*)(W + (size_t)k * NMODC);
        const float s0 = siluf(c_ctx[k]), s1 = siluf(c[k]), s2 = siluf(c[DM + k]);
        a0 += w * s0; a1 += w * s1; a2 += w * s2;
    }
    *(LAS f32x4*)(red + (wave * 3 + 0) * 256 + 4 * lane) = a0;
    *(LAS f32x4*)(red + (wave * 3 + 1) * 256 + 4 * lane) = a1;
    *(LAS f32x4*)(red + (wave * 3 + 2) * 256 + 4 * lane) = a2;
    __syncthreads();
    for (int e = tid; e < 768; e += 512) {
        const int g = e >> 8, col = e & 255; float s = 0.f;
#pragma unroll
        for (int w = 0; w < 8; ++w) s += red[(w * 3 + g) * 256 + col];
        if (kqr == 0) s += ada_b[l * NMODC + 256 * cc + col];
        unsafeAtomicAdd(mods + (size_t)(l * 3 + g) * NMODC + 256 * cc + col, s);
    }
    __syncthreads();
}

constexpr int GL_QD = 0, GL_KI = 8704, GL_KST = 17408, GL_VT = 26624, GL_TOT = 35840, GL_DV = 39936, GL_RED = 40448, GL_STASH = 41472, GL_SROW = 272;
__device__ __forceinline__ bf16x8 gl_frag(const LAS unsigned char* p) {
    const u32x2 a = *(const LAS u32x2*)p, b = *(const LAS u32x2*)(p + 32);
    u32x4 r; r.x = a.x; r.y = a.y; r.z = b.x; r.w = b.y; return __builtin_bit_cast(bf16x8, r);
}
__device__ __forceinline__ bf16x8 gl_pack(const f32x4& a, const f32x4& b) { u32x4 r; r.x = pk2(a[0], a[1]); r.y = pk2(a[2], a[3]); r.z = pk2(b[0], b[1]); r.w = pk2(b[2], b[3]); return __builtin_bit_cast(bf16x8, r); }

template <int MODE>
__device__ __forceinline__ void gla_pass(LAS unsigned char* L, const u16* Qp, const u16* Lp, const u16* Vp, u16* stash, const u16* Gp, u16* outp,
                                         int row0, int h, int dir, const float* Sinit, float* Sout, float* Dout, const float* gnw, int tid_in) {
    int tid = tid_in; asm volatile("" : "+v"(tid));
    const int wave = __builtin_amdgcn_readfirstlane(tid >> 6), lane = tid & 63, fr = lane & 15, kq = lane >> 4;
    const int hoff = h * 128;
    f32x4 S[8];
#pragma unroll
    for (int t = 0; t < 8; ++t)
#pragma unroll
        for (int i = 0; i < 4; ++i) S[t][i] = Sinit ? Sinit[(16 * t + 4 * kq + i) * 128 + 16 * wave + fr] : 0.f;
    float gs0 = 0.f, gs1 = 0.f;
    unsigned rq[4], rl[4], rv[4]; u16 rg_[2][4];
#define GLA_LOAD(ci) do { _Pragma("unroll") for (int j = 0; j < 4; ++j) { const int tau = 32 * (ci) + 4 * wave + j; const size_t ro = (size_t)(row0 + (dir ? 255 - tau : tau)) * DM + hoff + 2 * lane; \
        if (MODE != 0) rq[j] = *(const unsigned*)(Qp + ro); rl[j] = *(const unsigned*)(Lp + ro); rv[j] = *(const unsigned*)(Vp + ro); } \
        if (MODE == 2) { _Pragma("unroll") for (int ct = 0; ct < 2; ++ct) _Pragma("unroll") for (int i = 0; i < 4; ++i) { const int tau = 32 * (ci) + 16 * ct + 4 * kq + i; \
            const size_t ro = (size_t)(row0 + (dir ? 255 - tau : tau)) * DM + hoff + 16 * wave + fr; rg_[ct][i] = Gp[ro]; } } } while (0)
    GLA_LOAD(0);
#pragma unroll 1
    for (int ci = 0; ci < 8; ++ci) {
        float q0[4], q1[4], c0[4], c1[4], k0[4], k1[4]; unsigned vc[4];
#pragma unroll
        for (int j = 0; j < 4; ++j) { if (MODE != 0) { q0[j] = bflo(rq[j]); q1[j] = bfhi(rq[j]); } else { q0[j] = 0.f; q1[j] = 0.f; }
            const float l0 = hlo(rl[j]), l1 = hhi(rl[j]); k0[j] = 1.f - __expf(l0); k1[j] = 1.f - __expf(l1);
            c0[j] = l0 + (j ? c0[j ? j - 1 : 0] : 0.f); c1[j] = l1 + (j ? c1[j ? j - 1 : 0] : 0.f); vc[j] = rv[j]; }
        float gg_[2][4];
        if (MODE == 2) {
#pragma unroll
            for (int ct = 0; ct < 2; ++ct)
#pragma unroll
                for (int i = 0; i < 4; ++i) gg_[ct][i] = bf1(rg_[ct][i]);
        }
        if (ci < 7) GLA_LOAD(ci + 1);
        *(LAS f32x2*)(L + GL_TOT + (wave * 128 + 2 * lane) * 4) = (f32x2){c0[3], c1[3]};
        LBAR();
        float pre0 = 0.f, pre1 = 0.f, gl0 = 0.f, gl1 = 0.f;
#pragma unroll
        for (int g = 0; g < 8; ++g) { const f32x2 t = *(const LAS f32x2*)(L + GL_TOT + (g * 128 + 2 * lane) * 4); gl0 += t.x; gl1 += t.y; if (g < wave) { pre0 += t.x; pre1 += t.y; } }
        float ks0[4], ks1[4]; const float egl0 = __expf(gl0), egl1 = __expf(gl1);
#pragma unroll
        for (int j = 0; j < 4; ++j) {
            const float g0 = pre0 + c0[j], g1 = pre1 + c1[j];
            const float ki0 = k0[j] * __expf(-g0), ki1 = k1[j] * __expf(-g1);
            ks0[j] = ki0 * egl0; ks1[j] = ki1 * egl1;
            if (MODE != 0) {
                const int s = 4 * wave + j;
                *(LAS unsigned*)(L + GL_QD + s * 272 + 4 * lane) = pk2(q0[j] * __expf(g0), q1[j] * __expf(g1));
                *(LAS unsigned*)(L + GL_KI + s * 272 + 4 * lane) = pk2(ki0, ki1);
            }
        }
        { u32x2 a, b; a.x = pk2(ks0[0], ks0[1]); a.y = pk2(ks0[2], ks0[3]); b.x = pk2(ks1[0], ks1[1]); b.y = pk2(ks1[2], ks1[3]);
          *(LAS u32x2*)(L + GL_KST + (2 * lane) * 72 + 8 * wave) = a; *(LAS u32x2*)(L + GL_KST + (2 * lane + 1) * 72 + 8 * wave) = b;
          u32x2 c, d; c.x = (vc[0] & 0xffffu) | (vc[1] << 16); c.y = (vc[2] & 0xffffu) | (vc[3] << 16); d.x = (vc[0] >> 16) | (vc[1] & 0xffff0000u); d.y = (vc[2] >> 16) | (vc[3] & 0xffff0000u);
          *(LAS u32x2*)(L + GL_VT + (2 * lane) * 72 + 8 * wave) = c; *(LAS u32x2*)(L + GL_VT + (2 * lane + 1) * 72 + 8 * wave) = d; }
        if (wave == 0) { *(LAS f32x2*)(L + GL_DV + 8 * lane) = (f32x2){egl0, egl1}; gs0 += gl0; gs1 += gl1; }
        LBAR();
        const bf16x8 vb = gl_frag(L + GL_VT + (16 * wave + fr) * 72 + 8 * kq);
        f32x4 o[2] = {{0.f, 0.f, 0.f, 0.f}, {0.f, 0.f, 0.f, 0.f}};
        if (MODE != 0) {
            bf16x8 qf[2][4];
#pragma unroll
            for (int ct = 0; ct < 2; ++ct)
#pragma unroll
                for (int p = 0; p < 4; ++p) qf[ct][p] = gl_frag(L + GL_QD + (16 * ct + fr) * 272 + (32 * p + 4 * kq) * 2);
#pragma unroll
            for (int p = 0; p < 4; ++p) { const bf16x8 sb = gl_pack(S[2 * p], S[2 * p + 1]);
                o[0] = __builtin_amdgcn_mfma_f32_16x16x32_bf16(qf[0][p], sb, o[0], 0, 0, 0); o[1] = __builtin_amdgcn_mfma_f32_16x16x32_bf16(qf[1][p], sb, o[1], 0, 0, 0); }
            f32x4 s00 = {0.f, 0.f, 0.f, 0.f}, s01 = s00, s11 = s00;
#pragma unroll
            for (int p = 0; p < 4; ++p) {
                const bf16x8 kf0 = gl_frag(L + GL_KI + fr * 272 + (32 * p + 4 * kq) * 2), kf1 = gl_frag(L + GL_KI + (16 + fr) * 272 + (32 * p + 4 * kq) * 2);
                s00 = __builtin_amdgcn_mfma_f32_16x16x32_bf16(kf0, qf[0][p], s00, 0, 0, 0);
                s01 = __builtin_amdgcn_mfma_f32_16x16x32_bf16(kf0, qf[1][p], s01, 0, 0, 0);
                s11 = __builtin_amdgcn_mfma_f32_16x16x32_bf16(kf1, qf[1][p], s11, 0, 0, 0);
            }
#pragma unroll
            for (int i = 0; i < 4; ++i) if (4 * kq + i > fr) { s00[i] = 0.f; s11[i] = 0.f; }
            const f32x4 z4 = {0.f, 0.f, 0.f, 0.f};
            const bf16x8 pa0 = gl_pack(s00, z4), pa1 = gl_pack(s01, s11);
            o[0] = __builtin_amdgcn_mfma_f32_16x16x32_bf16(pa0, vb, o[0], 0, 0, 0); o[1] = __builtin_amdgcn_mfma_f32_16x16x32_bf16(pa1, vb, o[1], 0, 0, 0);
        }
#pragma unroll
        for (int t = 0; t < 8; ++t) {
            const f32x4 dv = *(const LAS f32x4*)(L + GL_DV + (16 * t + 4 * kq) * 4);
            const bf16x8 ka = gl_frag(L + GL_KST + (16 * t + fr) * 72 + 8 * kq);
            S[t] = S[t] * dv;
            S[t] = __builtin_amdgcn_mfma_f32_16x16x32_bf16(ka, vb, S[t], 0, 0, 0);
        }
        if (MODE == 1) {
#pragma unroll
            for (int ct = 0; ct < 2; ++ct)
#pragma unroll
                for (int i = 0; i < 4; ++i) { const int tau = 32 * ci + 16 * ct + 4 * kq + i, tok = dir ? 255 - tau : tau;
                    *(LAS u16*)(L + GL_STASH + tok * GL_SROW + (16 * wave + fr) * 2) = (u16)(pk2(o[ct][i], 0.f) & 0xffffu); }
        }
        if (MODE == 2) {
            float ov[2][4], ssv[2][4];
#pragma unroll
            for (int ct = 0; ct < 2; ++ct)
#pragma unroll
                for (int i = 0; i < 4; ++i) { const int tau = 32 * ci + 16 * ct + 4 * kq + i, tok = dir ? 255 - tau : tau;
                    ov[ct][i] = o[ct][i] + bf1(*(const LAS u16*)(L + GL_STASH + tok * GL_SROW + (16 * wave + fr) * 2));
                    ssv[ct][i] = row16_sum(ov[ct][i] * ov[ct][i]); }
            if (fr == 0) {
#pragma unroll
                for (int ct = 0; ct < 2; ++ct) *(LAS f32x4*)(L + GL_RED + (wave * 32 + 16 * ct + 4 * kq) * 4) = (f32x4){ssv[ct][0], ssv[ct][1], ssv[ct][2], ssv[ct][3]};
            }
            const float gw_ = gnw[16 * wave + fr];
            LBAR();
#pragma unroll
            for (int ct = 0; ct < 2; ++ct) {
                f32x4 tot = {0.f, 0.f, 0.f, 0.f};
#pragma unroll
                for (int w = 0; w < 8; ++w) tot += *(const LAS f32x4*)(L + GL_RED + (w * 32 + 16 * ct + 4 * kq) * 4);
#pragma unroll
                for (int i = 0; i < 4; ++i) { const int tau = 32 * ci + 16 * ct + 4 * kq + i, tok = dir ? 255 - tau : tau;
                    const float rstd = frsq(tot[i] * (1.f / 128.f) + EPSN);
                    *(LAS u16*)(L + GL_STASH + tok * GL_SROW + (16 * wave + fr) * 2) = (u16)(pk2(ov[ct][i] * rstd * gw_ * gg_[ct][i], 0.f) & 0xffffu); }
            }
        }
    }
#undef GLA_LOAD
    if (MODE == 2) {
        LBAR();
#pragma unroll
        for (int k = 0; k < 8; ++k) { const int pc = tid + 512 * k, row = pc >> 4, c16 = pc & 15;
            const u32x4 v = *(const LAS u32x4*)(L + GL_STASH + row * GL_SROW + c16 * 16);
            *(u32x4*)(outp + (size_t)(row0 + row) * DM + hoff + c16 * 8) = v; }
    }
    if (Sout) {
#pragma unroll
        for (int t = 0; t < 8; ++t)
#pragma unroll
            for (int i = 0; i < 4; ++i) Sout[(16 * t + 4 * kq + i) * 128 + 16 * wave + fr] = S[t][i];
    }
    if (MODE == 0 && wave == 0) { Dout[2 * lane] = __expf(gs0); Dout[2 * lane + 1] = __expf(gs1); }
    asm volatile("s_waitcnt vmcnt(0)" ::: "memory");
    __syncthreads();
}

__device__ __forceinline__ void sconv_rows(const u16* cu, const u16* gb, const float* cw, const float* cb, u16* A2, int gtid, int ngt) {
    for (int it = gtid; it < NTOK * 128; it += ngt) {
        const int row = it >> 7, c = (it & 127) * 8;
        bool hp, hn; int dlt;
        if (row < NCTX) { dlt = 1; const int t = row & 255; hp = t > 0; hn = t < 255; }
        else { dlt = 64; const int t = (row - NCTX) & 4095; hp = t >= 64; hn = t < 4096 - 64; }
        const u32x4 z = {0u, 0u, 0u, 0u};
        const u32x4 m = *(const u32x4*)(cu + (size_t)row * DM + c);
        const u32x4 p = hp ? *(const u32x4*)(cu + (size_t)(row - dlt) * DM + c) : z;
        const u32x4 n = hn ? *(const u32x4*)(cu + (size_t)(row + dlt) * DM + c) : z;
        const u32x4 g = *(const u32x4*)(gb + (size_t)row * DM + c);
        float w0[8], w1[8], w2[8], bb[8];
#pragma unroll
        for (int q = 0; q < 2; ++q) { const f32x4 a = *(const f32x4*)(cw + c + 4 * q), b = *(const f32x4*)(cw + DM + c + 4 * q), d = *(const f32x4*)(cw + 2 * DM + c + 4 * q), e = *(const f32x4*)(cb + c + 4 * q);
#pragma unroll
            for (int i = 0; i < 4; ++i) { w0[4 * q + i] = a[i]; w1[4 * q + i] = b[i]; w2[4 * q + i] = d[i]; bb[4 * q + i] = e[i]; } }
        u32x4 o;
#pragma unroll
        for (int q = 0; q < 4; ++q) {
            const float zl = w0[2 * q] * bflo(p[q]) + w1[2 * q] * bflo(m[q]) + w2[2 * q] * bflo(n[q]) + bb[2 * q];
            const float zh = w0[2 * q + 1] * bfhi(p[q]) + w1[2 * q + 1] * bfhi(m[q]) + w2[2 * q + 1] * bfhi(n[q]) + bb[2 * q + 1];
            o[q] = pk2(zl * bflo(g[q]), zh * bfhi(g[q]));
        }
        *(u32x4*)(A2 + (size_t)row * DM + c) = o;
    }
}

#ifndef PROBE
#define PROBE 0
#endif
#ifndef PH
#define PH 0x7fff
#endif
struct Args { const float* in[22]; float* out; unsigned char* ws; };
enum { I_XP = 0, I_XS, I_STATE, I_C, I_CCTX, I_ADAW, I_ADAB, I_NMIX, I_NFFN, I_HWIN, I_HLB, I_HGN, I_HWOUT, I_SWIN, I_SCW, I_SCB, I_SWOUT, I_FUP, I_FCW, I_FCB, I_FDN, I_FNW };

#define KAS __attribute__((address_space(4)))
#define GRID_BAR() do { const KAS Args* bp_ = (const KAS Args*)__builtin_amdgcn_kernarg_segment_ptr(); asm volatile("" : "+s"(bp_)); \
    XcdBarrier b_; b_.bar = (unsigned*)(bp_->ws + WS_CTL) + CW_BAR; b_.x = xb_xcc_id(); b_.st = (volatile LAS unsigned*)((LAS unsigned char*)lds + MISC_OFF) + 8; xcd_barrier(b_); } while (0)
#define PHASE_ENV() const KAS Args* ap_ = (const KAS Args*)__builtin_amdgcn_kernarg_segment_ptr(); asm volatile("" : "+s"(ap_)); \
    unsigned char* ws = ap_->ws; float* out = ap_->out; (void)ws; (void)out; \
    int tid_ = threadIdx.x; asm volatile("" : "+v"(tid_)); const int tid = tid_, lane = tid & 63, wave = __builtin_amdgcn_readfirstlane(tid >> 6); \
    const int G = gridDim.x, blk = blockIdx.x, gw = blk * NWAVES + wave, NGW = G * NWAVES; (void)lane; (void)gw; (void)NGW; \
    float* mods = (float*)(ws + WS_MODS); (void)mods
#define IN(k) (ap_->in[k])

__global__ void __launch_bounds__(NWAVES * 64, 2) hgrn_dit_fwd(Args args) {
    extern __shared__ __attribute__((aligned(16))) unsigned char lds[];
    LAS unsigned char* L = (LAS unsigned char*)lds;
    volatile LAS unsigned* MISC = (volatile LAS unsigned*)(L + MISC_OFF);
    for (int u = threadIdx.x; u < 32; u += NWAVES * 64) MISC[u] = 0u;
    __syncthreads();
    (void)xcd_barrier_post((unsigned*)(args.ws + WS_CTL) + CW_BAR, MISC + 8);

    {
        PHASE_ENV();
        if (PH & 1) if (blk < 192) mods_item(blk, IN(I_CCTX), IN(I_C), IN(I_ADAW), IN(I_ADAB), mods, (LAS float*)L, tid);
        if (blk == G - 1) {
            const float* lbnd = IN(I_HLB);
            float* lbv = (float*)(ws + WS_LB);
            for (int e = tid; e < 2048; e += NWAVES * 64) { const int dir = e >> 10, i = e & 1023; lbv[e] = frcp(1.f + __expf(lbnd[dir * 2048 + 1024 + i] - lbnd[dir * 2048 + i])); }
        }
        LAS float* scr = (LAS float*)(L + wave * 16384);
        constexpr int I_A = (DM / 64) * (5120 / 32), I_B = (DM / 64) * (DM / 32), I_C2 = (DM / 64) * (3072 / 32), I_U = (DM / 64) * (2 * DFF / 32), I_D = (DFF / 64) * (DM / 32);
        constexpr int NITEMS = I_A + I_B + I_C2 + I_B + 2 * I_U + 2 * I_D;
        if (PH & 2) for (int it = gw; it < NITEMS; it += NGW) {
            int r = it;
            if (r < I_A) { p0_transpose_item(IN(I_HWIN), DM, 5120, (u16*)(ws + WS_W_HIN), 0, scr, r, lane); continue; } r -= I_A;
            if (r < I_B) { p0_transpose_item(IN(I_HWOUT), DM, DM, (u16*)(ws + WS_W_HOUT), 0, scr, r, lane); continue; } r -= I_B;
            if (r < I_C2) { p0_transpose_item(IN(I_SWIN), DM, 3072, (u16*)(ws + WS_W_SIN), 2, scr, r, lane); continue; } r -= I_C2;
            if (r < I_B) { p0_transpose_item(IN(I_SWOUT), DM, DM, (u16*)(ws + WS_W_SOUT), 0, scr, r, lane); continue; } r -= I_B;
            if (r < I_U) { p0_transpose_item(IN(I_FUP), DM, 2 * DFF, (u16*)(ws + WS_W_UP0), 1, scr, r, lane); continue; } r -= I_U;
            if (r < I_U) { p0_transpose_item(IN(I_FUP) + (size_t)DM * 2 * DFF, DM, 2 * DFF, (u16*)(ws + WS_W_UP1), 1, scr, r, lane); continue; } r -= I_U;
            if (r < I_D) { p0_transpose_item(IN(I_FDN), DFF, DM, (u16*)(ws + WS_W_DN0), 0, scr, r, lane); continue; } r -= I_D;
            p0_transpose_item(IN(I_FDN) + (size_t)DFF * DM, DFF, DM, (u16*)(ws + WS_W_DN1), 0, scr, r, lane);
        }
    }
    GRID_BAR();

    if (PH & 4) { PHASE_ENV(); float* rowss = (float*)(ws + WS_ROWSS); float* bias = (float*)(ws + WS_BIAS);
        premod_rows(IN(I_XP), IN(I_XS), IN(I_NMIX), mods + 1 * 1024, (u16*)(ws + WS_H), rowss, gw, NGW, lane);
        for (int r = gw; r < 5120 + 5632 + 3072 + 5632; r += NGW) {
            if (r < 5120) bias_row((const u16*)(ws + WS_W_HIN), r, mods + 0 * 1024, bias, lane);
            else if (r < 5120 + 5632) bias_row((const u16*)(ws + WS_W_UP0), r - 5120, mods + 3 * 1024, bias + BIAS_STRIDE, lane);
            else if (r < 5120 + 5632 + 3072) bias_row((const u16*)(ws + WS_W_SIN), r - 5120 - 5632, mods + 3 * NMODC + 0 * 1024, bias + 2 * BIAS_STRIDE, lane);
            else bias_row((const u16*)(ws + WS_W_UP1), r - 5120 - 5632 - 3072, mods + 3 * NMODC + 3 * 1024, bias + 3 * BIAS_STRIDE, lane);
        }
    }
    GRID_BAR();

#if PROBE == 3
    { PHASE_ENV();
        LAS float* scr = (LAS float*)(L + wave * 16384);
        constexpr int I_A = (DM / 64) * (5120 / 32), I_B = (DM / 64) * (DM / 32), I_C2 = (DM / 64) * (3072 / 32), I_U = (DM / 64) * (2 * DFF / 32), I_D = (DFF / 64) * (DM / 32);
        constexpr int NITEMS = I_A + I_B + I_C2 + I_B + 2 * I_U + 2 * I_D;
        if (PH & 2) for (int it = gw; it < NITEMS; it += NGW) {
            int r = it;
            if (r < I_A) { p0_transpose_item(IN(I_HWIN), DM, 5120, (u16*)(ws + WS_W_HIN), 0, scr, r, lane); continue; } r -= I_A;
            if (r < I_B) { p0_transpose_item(IN(I_HWOUT), DM, DM, (u16*)(ws + WS_W_HOUT), 0, scr, r, lane); continue; } r -= I_B;
            if (r < I_C2) { p0_transpose_item(IN(I_SWIN), DM, 3072, (u16*)(ws + WS_W_SIN), 2, scr, r, lane); continue; } r -= I_C2;
            if (r < I_B) { p0_transpose_item(IN(I_SWOUT), DM, DM, (u16*)(ws + WS_W_SOUT), 0, scr, r, lane); continue; } r -= I_B;
            if (r < I_U) { p0_transpose_item(IN(I_FUP), DM, 2 * DFF, (u16*)(ws + WS_W_UP0), 1, scr, r, lane); continue; } r -= I_U;
            if (r < I_U) { p0_transpose_item(IN(I_FUP) + (size_t)DM * 2 * DFF, DM, 2 * DFF, (u16*)(ws + WS_W_UP1), 1, scr, r, lane); continue; } r -= I_U;
            if (r < I_D) { p0_transpose_item(IN(I_FDN), DFF, DM, (u16*)(ws + WS_W_DN0), 0, scr, r, lane); continue; } r -= I_D;
            p0_transpose_item(IN(I_FDN) + (size_t)DFF * DM, DFF, DM, (u16*)(ws + WS_W_DN1), 0, scr, r, lane);
        }
    }
    GRID_BAR();
    if (PH & 4) { PHASE_ENV(); float* rowss = (float*)(ws + WS_ROWSS); float* bias = (float*)(ws + WS_BIAS);
        premod_rows(IN(I_XP), IN(I_XS), IN(I_NMIX), mods + 1 * 1024, (u16*)(ws + WS_H), rowss, gw, NGW, lane);
        for (int r = gw; r < 5120 + 5632 + 3072 + 5632; r += NGW) {
            if (r < 5120) bias_row((const u16*)(ws + WS_W_HIN), r, mods + 0 * 1024, bias, lane);
            else if (r < 5120 + 5632) bias_row((const u16*)(ws + WS_W_UP0), r - 5120, mods + 3 * 1024, bias + BIAS_STRIDE, lane);
            else if (r < 5120 + 5632 + 3072) bias_row((const u16*)(ws + WS_W_SIN), r - 5120 - 5632, mods + 3 * NMODC + 0 * 1024, bias + 2 * BIAS_STRIDE, lane);
            else bias_row((const u16*)(ws + WS_W_UP1), r - 5120 - 5632 - 3072, mods + 3 * NMODC + 3 * 1024, bias + 3 * BIAS_STRIDE, lane);
        }
    }
    GRID_BAR();

#endif
#pragma unroll
    for (int layer = 0; layer < 2; ++layer) {
        if (layer == 0) {
            for (int rp2_ = 0; rp2_ < (PROBE == 2 ? 2 : 1); ++rp2_) {
            if (PH & 8) { PHASE_ENV(); pg8::Gemm g{(const u16*)(ws + WS_H), (const u16*)(ws + WS_W_HIN), NTOK, 5120, DM}; pg8::StaticOrder S; S.init(NTOK, 5120, G, blk);
              EpiProj E{(u16*)(ws + WS_BIG), (const float*)(ws + WS_LB), (const float*)(ws + WS_ROWSS), (const float*)(ws + WS_BIAS), (LAS float*)(L + XCH_OFF)};
              pg8::gemm_phase<EpiProj, pg8::StaticOrder, true, true>(L, g, S, E); }
            GRID_BAR();
            }
            for (int rp4_ = 0; rp4_ < (PROBE == 4 ? 2 : 1); ++rp4_) { if (rp4_) GRID_BAR();
            if (PH & 16) for (int idx = blockIdx.x; idx < 512; idx += gridDim.x) {
                PHASE_ENV(); u16* BIG = (u16*)(ws + WS_BIG); float* SEGKV = (float*)(ws + WS_H); float* SEGD = (float*)(ws + WS_SEGD);
                const int b = idx >> 8, h = (idx >> 5) & 7, dir = (idx >> 4) & 1, seg = idx & 15;
                if ((dir == 0 && seg == 15) || (dir == 1 && seg == 0)) continue;
                gla_pass<0>(L, nullptr, BIG + (dir ? 2 : 1) * PL, BIG + 3 * PL, nullptr, nullptr, nullptr, NCTX + b * 4096 + seg * 256, h, dir, nullptr, SEGKV + (size_t)idx * 16384, SEGD + (size_t)idx * 128, nullptr, tid);
            }
            }
            GRID_BAR();
            if (PH & 32) for (int w = blockIdx.x; w < 256; w += gridDim.x) {
                PHASE_ENV(); float* SEGKV = (float*)(ws + WS_H); const float* SEGD = (const float*)(ws + WS_SEGD);
                const int chain = w >> 3, part = w & 7, e4 = (part * 512 + tid) * 4, d = e4 >> 7;
                const int dir = chain & 1, bh = chain >> 1;
                const int b = bh >> 3, h = bh & 7;
                f32x4 S = *(const f32x4*)(IN(I_STATE) + ((size_t)((b * 2 + dir) * 8 + h)) * 16384 + e4);
                f32x4 kv[15]; float dd[15];
#pragma unroll
                for (int k = 0; k < 15; ++k) { const int seg = dir ? 15 - k : k; kv[k] = *(const f32x4*)(SEGKV + ((size_t)chain * 16 + seg) * 16384 + e4); dd[k] = SEGD[((size_t)chain * 16 + seg) * 128 + d]; }
#pragma unroll
                for (int k = 0; k < 16; ++k) { const int seg = dir ? 15 - k : k; *(f32x4*)(SEGKV + ((size_t)chain * 16 + seg) * 16384 + e4) = S; if (k < 15) S = S * dd[k < 15 ? k : 0] + kv[k < 15 ? k : 0]; }
            }
            GRID_BAR();
            if (PH & 64) for (int it = blockIdx.x; it < 512; it += gridDim.x) {
                PHASE_ENV(); u16* BIG = (u16*)(ws + WS_BIG); const float* SEGKV = (const float*)(ws + WS_H);
                int row0, h; const float *sif = nullptr, *sib = nullptr; float *sof = nullptr, *sob = nullptr;
                if (it < 256) { const int b = it >> 3; h = it & 7; row0 = b * 256;
                    sof = out + (size_t)NTOK * DM + ((size_t)((b * 2 + 0) * 8 + h)) * 16384; sob = out + (size_t)NTOK * DM + ((size_t)((b * 2 + 1) * 8 + h)) * 16384; }
                else { const int idx = it - 256, b = idx >> 7, seg = idx & 15; h = (idx >> 4) & 7; row0 = NCTX + b * 4096 + seg * 256;
                    sif = SEGKV + ((size_t)(((b * 8 + h) * 2 + 0) * 16 + seg)) * 16384; sib = SEGKV + ((size_t)(((b * 8 + h) * 2 + 1) * 16 + seg)) * 16384; }
                gla_pass<1>(L, BIG, BIG + PL, BIG + 3 * PL, BIG + PL, nullptr, nullptr, row0, h, 0, sif, sof, nullptr, nullptr, tid);
                gla_pass<2>(L, BIG, BIG + 2 * PL, BIG + 3 * PL, BIG + PL, BIG + 4 * PL, BIG, row0, h, 1, sib, sob, nullptr, IN(I_HGN), tid);
            }
            GRID_BAR();
#if PROBE == 1
            {
    if (PH & 4) { PHASE_ENV(); float* rowss = (float*)(ws + WS_ROWSS); float* bias = (float*)(ws + WS_BIAS);
        premod_rows(IN(I_XP), IN(I_XS), IN(I_NMIX), mods + 1 * 1024, (u16*)(ws + WS_H), rowss, gw, NGW, lane);
        for (int r = gw; r < 5120 + 5632 + 3072 + 5632; r += NGW) {
            if (r < 5120) bias_row((const u16*)(ws + WS_W_HIN), r, mods + 0 * 1024, bias, lane);
            else if (r < 5120 + 5632) bias_row((const u16*)(ws + WS_W_UP0), r - 5120, mods + 3 * 1024, bias + BIAS_STRIDE, lane);
            else if (r < 5120 + 5632 + 3072) bias_row((const u16*)(ws + WS_W_SIN), r - 5120 - 5632, mods + 3 * NMODC + 0 * 1024, bias + 2 * BIAS_STRIDE, lane);
            else bias_row((const u16*)(ws + WS_W_UP1), r - 5120 - 5632 - 3072, mods + 3 * NMODC + 3 * 1024, bias + 3 * BIAS_STRIDE, lane);
        }
    }
    GRID_BAR();

            for (int rp2_ = 0; rp2_ < (PROBE == 2 ? 2 : 1); ++rp2_) {
            if (PH & 8) { PHASE_ENV(); pg8::Gemm g{(const u16*)(ws + WS_H), (const u16*)(ws + WS_W_HIN), NTOK, 5120, DM}; pg8::StaticOrder S; S.init(NTOK, 5120, G, blk);
              EpiProj E{(u16*)(ws + WS_BIG), (const float*)(ws + WS_LB), (const float*)(ws + WS_ROWSS), (const float*)(ws + WS_BIAS), (LAS float*)(L + XCH_OFF)};
              pg8::gemm_phase<EpiProj, pg8::StaticOrder, true, true>(L, g, S, E); }
            GRID_BAR();
            }
            for (int rp4_ = 0; rp4_ < (PROBE == 4 ? 2 : 1); ++rp4_) { if (rp4_) GRID_BAR();
            if (PH & 16) for (int idx = blockIdx.x; idx < 512; idx += gridDim.x) {
                PHASE_ENV(); u16* BIG = (u16*)(ws + WS_BIG); float* SEGKV = (float*)(ws + WS_H); float* SEGD = (float*)(ws + WS_SEGD);
                const int b = idx >> 8, h = (idx >> 5) & 7, dir = (idx >> 4) & 1, seg = idx & 15;
                if ((dir == 0 && seg == 15) || (dir == 1 && seg == 0)) continue;
                gla_pass<0>(L, nullptr, BIG + (dir ? 2 : 1) * PL, BIG + 3 * PL, nullptr, nullptr, nullptr, NCTX + b * 4096 + seg * 256, h, dir, nullptr, SEGKV + (size_t)idx * 16384, SEGD + (size_t)idx * 128, nullptr, tid);
            }
            }
            GRID_BAR();
            if (PH & 32) for (int w = blockIdx.x; w < 256; w += gridDim.x) {
                PHASE_ENV(); float* SEGKV = (float*)(ws + WS_H); const float* SEGD = (const float*)(ws + WS_SEGD);
                const int chain = w >> 3, part = w & 7, e4 = (part * 512 + tid) * 4, d = e4 >> 7;
                const int dir = chain & 1, bh = chain >> 1;
                const int b = bh >> 3, h = bh & 7;
                f32x4 S = *(const f32x4*)(IN(I_STATE) + ((size_t)((b * 2 + dir) * 8 + h)) * 16384 + e4);
                f32x4 kv[15]; float dd[15];
#pragma unroll
                for (int k = 0; k < 15; ++k) { const int seg = dir ? 15 - k : k; kv[k] = *(const f32x4*)(SEGKV + ((size_t)chain * 16 + seg) * 16384 + e4); dd[k] = SEGD[((size_t)chain * 16 + seg) * 128 + d]; }
#pragma unroll
                for (int k = 0; k < 16; ++k) { const int seg = dir ? 15 - k : k; *(f32x4*)(SEGKV + ((size_t)chain * 16 + seg) * 16384 + e4) = S; if (k < 15) S = S * dd[k < 15 ? k : 0] + kv[k < 15 ? k : 0]; }
            }
            GRID_BAR();
            if (PH & 64) for (int it = blockIdx.x; it < 512; it += gridDim.x) {
                PHASE_ENV(); u16* BIG = (u16*)(ws + WS_BIG); const float* SEGKV = (const float*)(ws + WS_H);
                int row0, h; const float *sif = nullptr, *sib = nullptr; float *sof = nullptr, *sob = nullptr;
                if (it < 256) { const int b = it >> 3; h = it & 7; row0 = b * 256;
                    sof = out + (size_t)NTOK * DM + ((size_t)((b * 2 + 0) * 8 + h)) * 16384; sob = out + (size_t)NTOK * DM + ((size_t)((b * 2 + 1) * 8 + h)) * 16384; }
                else { const int idx = it - 256, b = idx >> 7, seg = idx & 15; h = (idx >> 4) & 7; row0 = NCTX + b * 4096 + seg * 256;
                    sif = SEGKV + ((size_t)(((b * 8 + h) * 2 + 0) * 16 + seg)) * 16384; sib = SEGKV + ((size_t)(((b * 8 + h) * 2 + 1) * 16 + seg)) * 16384; }
                gla_pass<1>(L, BIG, BIG + PL, BIG + 3 * PL, BIG + PL, nullptr, nullptr, row0, h, 0, sif, sof, nullptr, nullptr, tid);
                gla_pass<2>(L, BIG, BIG + 2 * PL, BIG + 3 * PL, BIG + PL, BIG + 4 * PL, BIG, row0, h, 1, sib, sob, nullptr, IN(I_HGN), tid);
            }
            GRID_BAR();
            }
#endif
            if (PH & 128) { PHASE_ENV(); pg8::Gemm g{(const u16*)(ws + WS_BIG), (const u16*)(ws + WS_W_HOUT), NTOK, DM, DM}; pg8::StaticOrder S; S.init(NTOK, DM, G, blk);
              EpiRes<1> E{IN(I_XP), IN(I_XS), out, mods + 2 * 1024, (u16*)(ws + WS_H), IN(I_NFFN), mods + 4 * 1024, (float*)(ws + WS_ROWSS) + 1 * RSS_STRIDE, (LAS float*)(L + XCH_OFF)};
              pg8::gemm_phase<EpiRes<1>, pg8::StaticOrder, true, true>(L, g, S, E); }
        } else {
            if (PH & 256) { PHASE_ENV(); u16* BIG = (u16*)(ws + WS_BIG); pg8::Gemm g{(const u16*)(ws + WS_H), (const u16*)(ws + WS_W_SIN), NTOK, 3072, DM}; pg8::StaticOrder S; S.init(NTOK, 3072, G, blk);
              EpiSconvIn E{BIG, BIG + PL, (const float*)(ws + WS_ROWSS) + 2 * RSS_STRIDE, (const float*)(ws + WS_BIAS) + 2 * BIAS_STRIDE, (LAS float*)(L + XCH_OFF)};
              pg8::gemm_phase<EpiSconvIn, pg8::StaticOrder, true, true>(L, g, S, E); }
            GRID_BAR();
            if (PH & 512) { PHASE_ENV(); u16* BIG = (u16*)(ws + WS_BIG); sconv_rows(BIG, BIG + PL, IN(I_SCW), IN(I_SCB), BIG + 2 * PL, blk * NWAVES * 64 + tid, G * NWAVES * 64); }
            GRID_BAR();
            if (PH & 1024) { PHASE_ENV(); pg8::Gemm g{(const u16*)(ws + WS_BIG) + 2 * PL, (const u16*)(ws + WS_W_SOUT), NTOK, DM, DM}; pg8::StaticOrder S; S.init(NTOK, DM, G, blk);
              EpiRes<1> E{out, out + (size_t)NCTX * DM, out, mods + 3 * NMODC + 2 * 1024, (u16*)(ws + WS_H), IN(I_NFFN) + DM, mods + 3 * NMODC + 4 * 1024, (float*)(ws + WS_ROWSS) + 3 * RSS_STRIDE, (LAS float*)(L + XCH_OFF)};
              pg8::gemm_phase<EpiRes<1>, pg8::StaticOrder, true, true>(L, g, S, E); }
        }
        GRID_BAR();
        if (PH & 4096) { PHASE_ENV(); pg8::Gemm g{(const u16*)(ws + WS_H), (const u16*)(ws + (layer ? WS_W_UP1 : WS_W_UP0)), NTOK, 2 * DFF, DM}; pg8::StaticOrder S; S.init(NTOK, 2 * DFF, G, blk);
          EpiFfnUp E{(u16*)(ws + WS_BIG), IN(I_FCW) + (size_t)layer * 3 * DFF, IN(I_FCB) + (size_t)layer * DFF, (LAS float*)(L + XCH_OFF), (const float*)(ws + WS_ROWSS) + (layer ? 3 : 1) * RSS_STRIDE, (const float*)(ws + WS_BIAS) + (layer ? 3 : 1) * BIAS_STRIDE};
          pg8::gemm_phase<EpiFfnUp, pg8::StaticOrder, true, true>(L, g, S, E); }
        GRID_BAR();
        if (PH & 8192) { PHASE_ENV(); pg8::Gemm g{(const u16*)(ws + WS_BIG), (const u16*)(ws + (layer ? WS_W_DN1 : WS_W_DN0)), NTOK, DM, DFF}; pg8::StaticOrder S; S.init(NTOK, DM, G, blk);
          if (layer == 0) { EpiRes<1> E{out, out + (size_t)NCTX * DM, out, mods + 5 * 1024, (u16*)(ws + WS_H), IN(I_NMIX) + DM, mods + 3 * NMODC + 1 * 1024, (float*)(ws + WS_ROWSS) + 2 * RSS_STRIDE, (LAS float*)(L + XCH_OFF)};
            pg8::gemm_phase<EpiRes<1>, pg8::StaticOrder, true, true>(L, g, S, E); }
          else { EpiRes<2> E{out, out + (size_t)NCTX * DM, out, mods + 3 * NMODC + 5 * 1024, nullptr, nullptr, nullptr, (float*)(ws + WS_ROWSS) + 4 * RSS_STRIDE, (LAS float*)(L + XCH_OFF)};
            pg8::gemm_phase<EpiRes<2>, pg8::StaticOrder, true, true>(L, g, S, E); } }
        GRID_BAR();
    }
    if (PH & 16384) { PHASE_ENV(); final_norm_rows(out, IN(I_FNW), (const float*)(ws + WS_ROWSS) + 4 * RSS_STRIDE, gw, NGW, lane); }
}

extern "C" void kernel_launch(void* const* d_in, const int* in_sizes, int n_in, void* d_out, int out_size, void* d_ws, size_t ws_size, hipStream_t stream) {
    static int grid = 0;
    if (grid == 0) {
        if (n_in != 22 || ws_size < WS_END) { fprintf(stderr, "kernel_launch: unexpected inputs (n_in %d, ws %zu)\n", n_in, ws_size); grid = -1; return; }
        int dev = 0, cus = 0, per_cu = 0;
        if (hipGetDevice(&dev) != hipSuccess || hipDeviceGetAttribute(&cus, hipDeviceAttributeMultiprocessorCount, dev) != hipSuccess) { grid = -1; return; }
        if (hipFuncSetAttribute((const void*)hgrn_dit_fwd, hipFuncAttributeMaxDynamicSharedMemorySize, LDS_BYTES) != hipSuccess) { fprintf(stderr, "kernel_launch: hipFuncSetAttribute failed\n"); grid = -1; return; }
        if (hipOccupancyMaxActiveBlocksPerMultiprocessor(&per_cu, (const void*)hgrn_dit_fwd, NWAVES * 64, LDS_BYTES) != hipSuccess || per_cu < 1) { fprintf(stderr, "kernel_launch: occupancy query says %d\n", per_cu); (void)hipGetLastError(); grid = -1; return; }
        grid = cus;
    }
    if (grid < 0) return;
    (void)hipMemsetAsync((char*)d_ws + WS_CTL, 0, CTL_ZERO_BYTES, stream);
    Args a{};
    for (int i = 0; i < 22; ++i) a.in[i] = (const float*)d_in[i];
    a.out = (float*)d_out; a.ws = (unsigned char*)d_ws;
    void* kargs[] = {&a};
    hipError_t e = hipLaunchCooperativeKernel((const void*)hgrn_dit_fwd, dim3(grid), dim3(NWAVES * 64), kargs, LDS_BYTES, stream);
    if (e != hipSuccess) fprintf(stderr, "kernel_launch: cooperative launch failed: %s (grid %d)\n", hipGetErrorString(e), grid);
}
```

```cpp
#include <hip/hip_runtime.h>
#include <cstdio>
#include <cstdint>
typedef float f32x2 __attribute__((ext_vector_type(2)));
namespace pg8 {
#define PG8_LAS __attribute__((address_space(3)))
typedef unsigned short bf16_t;
typedef short bf16x8 __attribute__((ext_vector_type(8)));
typedef float f32x4 __attribute__((ext_vector_type(4)));
typedef unsigned u32x4 __attribute__((ext_vector_type(4)));
constexpr int BM = 256, BK = 64, HALF = 128, HTB = HALF * BK * 2  , STAGE_BYTES = 8 * HTB, NXCD = 8, WGM = 8;

__host__ __device__ __forceinline__ int lds_byte(int r, int c) { const int st = (r >> 4) * 2 + (c >> 5), rr = r & 15, cc = c & 31, ob = rr * 64 + cc * 2; return st * 1024 + (ob ^ (((ob >> 9) & 1) << 5)); }
__host__ __device__ __forceinline__ void stage_rc(int b, int& R, int& C) { const int st = b / 1024, sb = b % 1024, swz = sb ^ (((sb >> 9) & 1) << 5); R = (st >> 1) * 16 + swz / 64; C = (st & 1) * 32 + (swz % 64) / 2; }
__host__ __device__ __forceinline__ int perm32(int rho) { const int n = rho >> 4, i = rho & 15; return 8 * (i >> 2) + 4 * n + (i & 3); }

struct Unit { int pm, pn; };
struct Gemm { const bf16_t* A; const bf16_t* Bt; int M, N, K; };

struct StaticOrder {
    int nM, nN, nwg, G, c;
    __host__ __device__ void init(int M, int N, int G_, int c_) { nM = M / BM; nN = N / BM; nwg = nM * nN; G = G_; c = c_; }
    __host__ __device__ bool next(int i, Unit& u) const {
        const long L = (long)i * G + c; if (L >= nwg) return false;
        int wgid = (int)L; { const int q = nwg / NXCD, r = nwg % NXCD, xcd = wgid % NXCD, off = wgid / NXCD; wgid = (xcd < r ? xcd * (q + 1) : r * (q + 1) + (xcd - r) * q) + off; }
        const int nig = WGM * nN, gid = wgid / nig, fm = gid * WGM, gsz = (nM - fm) < WGM ? (nM - fm) : WGM;
        u.pm = fm + ((wgid % nig) % gsz); u.pn = (wgid % nig) / gsz; return true;
    }
    __device__ __forceinline__ void a_ready(const Unit&) const {}
    __device__ __forceinline__ void done(const Unit&) const {}
};

template <class Epi, class Sched, bool ALIGN_EPI = false, bool SP2 = false>
__device__ __forceinline__ void gemm_phase(PG8_LAS unsigned char* lds, const Gemm g, const Sched& S, const Epi& E) {
    int tid_ = threadIdx.x; asm volatile("" : "+v"(tid_));
    const int tid = tid_, wid = __builtin_amdgcn_readfirstlane(tid >> 6), lane = tid & 63, wr = wid >> 2, wc = wid & 3, fr = lane & 15, fq = lane >> 4;
    const int K = g.K, nt = K / BK;
    unsigned voffA[2], voffB[2];
#pragma unroll
    for (int i = 0; i < 2; ++i) { int R, C; stage_rc(tid * 16 + i * 8192, R, C); const int Rb = Epi::PERM ? ((R & ~31) + perm32(R & 31)) : R;
        voffA[i] = (unsigned)(R * K + C) * 2u; voffB[i] = (unsigned)(Rb * K + C) * 2u; }
    const size_t kstep = (size_t)(BK * 2);
    const size_t hstep = (size_t)HALF * K * 2;
    const size_t tstep = 2 * hstep;
    const unsigned ldsw = (unsigned)wid * 1024u;
    const int aoff = lds_byte(wr * 64 + fr, fq * 8), boff = lds_byte(wc * 32 + fr, fq * 8);
#define PG8_SA(b, h) (((b) * 2 + (h)) * HTB)
#define PG8_SB(b, h) ((4 + (b) * 2 + (h)) * HTB)
#define PG8_STAGE(bufoff, gbase, voff) do { _Pragma("unroll") for (int _i = 0; _i < 2; ++_i) \
        __builtin_amdgcn_global_load_lds((const unsigned*)((const char*)(gbase) + (voff)[_i]), (PG8_LAS unsigned*)(lds + (bufoff) + ldsw + _i * 8192), 16, 0, 0); } while (0)
#define PG8_LDA(dst, b, h) do { _Pragma("unroll") for (int m = 0; m < 4; ++m) _Pragma("unroll") for (int k = 0; k < 2; ++k) dst[m][k] = *(const PG8_LAS bf16x8*)(lds + PG8_SA(b, h) + aoff + m * 2048 + k * 1024); } while (0)
#define PG8_LDB(dst, b, h) do { _Pragma("unroll") for (int n = 0; n < 2; ++n) _Pragma("unroll") for (int k = 0; k < 2; ++k) dst[n][k] = *(const PG8_LAS bf16x8*)(lds + PG8_SB(b, h) + boff + n * 2048 + k * 1024); } while (0)
#define PG8_MMA(ai, bj, At, Bt) do { __builtin_amdgcn_s_setprio(1); _Pragma("unroll") for (int m = 0; m < 4; ++m) _Pragma("unroll") for (int n = 0; n < 2; ++n) _Pragma("unroll") for (int k = 0; k < 2; ++k) \
        acc[ai][bj][m][n] = __builtin_amdgcn_mfma_f32_16x16x32_bf16(Bt[n][k], At[m][k], acc[ai][bj][m][n], 0, 0, 0); __builtin_amdgcn_s_setprio(0); } while (0)
#define PG8_WAIT_V(n) asm volatile("s_waitcnt vmcnt(" #n ")" ::: "memory")
#define PG8_WAIT_L(n) asm volatile("s_waitcnt lgkmcnt(" #n ")" ::: "memory")
#define PG8_BAR __builtin_amdgcn_s_barrier()
#define PG8_SCHED __builtin_amdgcn_sched_barrier(0)
    Unit cur, nxt; int ui = 0;
    if (!S.next(0, cur)) return;
    f32x4 acc[2][2][4][2];
#pragma unroll
    for (int a = 0; a < 2; ++a)
#pragma unroll
        for (int b = 0; b < 2; ++b)
#pragma unroll
            for (int m = 0; m < 4; ++m)
#pragma unroll
                for (int n = 0; n < 2; ++n) acc[a][b][m][n] = (f32x4){0.f, 0.f, 0.f, 0.f};
    bf16x8 At[4][2], B0[2][2], B1[2][2];
    const char* cA = (const char*)g.A + (size_t)cur.pm * tstep; const char* cB = (const char*)g.Bt + (size_t)cur.pn * tstep;
    S.a_ready(cur);
    if constexpr (SP2) {
        PG8_STAGE(PG8_SB(0, 0), cB, voffB); PG8_STAGE(PG8_SB(0, 1), cB + hstep, voffB); PG8_STAGE(PG8_SA(0, 0), cA, voffA); PG8_STAGE(PG8_SA(0, 1), cA + hstep, voffA);
        if (wr == 1) PG8_BAR;
        PG8_WAIT_V(2); PG8_BAR;
        PG8_STAGE(PG8_SB(1, 0), cB + kstep, voffB); PG8_STAGE(PG8_SA(1, 0), cA + kstep, voffA); PG8_STAGE(PG8_SB(1, 1), cB + hstep + kstep, voffB);
        PG8_WAIT_V(6); PG8_BAR;
    } else {
        PG8_STAGE(PG8_SB(0, 0), cB, voffB); PG8_STAGE(PG8_SA(0, 0), cA, voffA); PG8_STAGE(PG8_SB(0, 1), cB + hstep, voffB); PG8_STAGE(PG8_SA(0, 1), cA + hstep, voffA);
        if (wr == 1) PG8_BAR;
        PG8_WAIT_V(4); PG8_BAR;
        PG8_STAGE(PG8_SB(1, 0), cB + kstep, voffB); PG8_STAGE(PG8_SA(1, 0), cA + kstep, voffA); PG8_STAGE(PG8_SB(1, 1), cB + hstep + kstep, voffB);
        PG8_WAIT_V(6); PG8_BAR;
    }
    for (;;) {
        const bool has_next = S.next(ui + 1, nxt);
        const char* nA = has_next ? (const char*)g.A + (size_t)nxt.pm * tstep : cA; const char* nB = has_next ? (const char*)g.Bt + (size_t)nxt.pn * tstep : cB;
        for (int t = 0; t < nt; t += 2) {
            const bool last = (t == nt - 2);
            const char* a1 = cA + (size_t)(t + 1) * kstep;
            const char* a2 = last ? nA : cA + (size_t)(t + 2) * kstep; const char* b2 = last ? nB : cB + (size_t)(t + 2) * kstep;
            const char* a3 = a2 + kstep; const char* b3 = b2 + kstep;
            if (last && has_next) S.a_ready(nxt);
            if constexpr (SP2) {
            PG8_LDB(B0, 0, 0); PG8_LDB(B1, 0, 1); PG8_SCHED; PG8_LDA(At, 0, 0); PG8_STAGE(PG8_SA(1, 1), a1 + hstep, voffA);
            PG8_WAIT_V(8); PG8_WAIT_L(0); PG8_BAR; PG8_MMA(0, 0, At, B0); PG8_MMA(0, 1, At, B1); PG8_BAR; PG8_SCHED;
            PG8_LDA(At, 0, 1); PG8_STAGE(PG8_SB(0, 0), b2, voffB); PG8_STAGE(PG8_SB(0, 1), b2 + hstep, voffB); PG8_STAGE(PG8_SA(0, 0), a2, voffA);
            PG8_WAIT_V(8); PG8_WAIT_L(0); PG8_BAR; PG8_MMA(1, 0, At, B0); PG8_MMA(1, 1, At, B1); PG8_BAR; PG8_SCHED;
            PG8_LDB(B0, 1, 0); PG8_LDB(B1, 1, 1); PG8_SCHED; PG8_LDA(At, 1, 0); PG8_STAGE(PG8_SA(0, 1), a2 + hstep, voffA);
            PG8_WAIT_V(8); PG8_WAIT_L(0); PG8_BAR; PG8_MMA(0, 0, At, B0); PG8_MMA(0, 1, At, B1); PG8_BAR; PG8_SCHED;
            PG8_LDA(At, 1, 1); PG8_STAGE(PG8_SB(1, 0), b3, voffB); PG8_STAGE(PG8_SB(1, 1), b3 + hstep, voffB); PG8_STAGE(PG8_SA(1, 0), a3, voffA);
            PG8_WAIT_V(8); PG8_WAIT_L(0); PG8_BAR; PG8_MMA(1, 0, At, B0); PG8_MMA(1, 1, At, B1); PG8_BAR; PG8_SCHED;
            } else {
            PG8_LDB(B0, 0, 0); PG8_SCHED; PG8_LDA(At, 0, 0); PG8_STAGE(PG8_SA(1, 1), a1 + hstep, voffA);
            PG8_WAIT_L(8); PG8_BAR; PG8_WAIT_L(0); PG8_MMA(0, 0, At, B0); PG8_BAR; PG8_SCHED;
            PG8_LDB(B1, 0, 1); PG8_STAGE(PG8_SB(0, 0), b2, voffB);
            PG8_BAR; PG8_WAIT_L(0); PG8_MMA(0, 1, At, B1); PG8_BAR;
            PG8_LDA(At, 0, 1); PG8_STAGE(PG8_SA(0, 0), a2, voffA);
            PG8_BAR; PG8_WAIT_L(0); PG8_MMA(1, 0, At, B0); PG8_BAR; PG8_SCHED;
            PG8_STAGE(PG8_SB(0, 1), b2 + hstep, voffB);
            PG8_WAIT_V(6); PG8_BAR; PG8_MMA(1, 1, At, B1); PG8_BAR;
            PG8_LDB(B0, 1, 0); PG8_SCHED; PG8_LDA(At, 1, 0); PG8_STAGE(PG8_SA(0, 1), a2 + hstep, voffA);
            PG8_WAIT_L(8); PG8_BAR; PG8_WAIT_L(0); PG8_MMA(0, 0, At, B0); PG8_BAR; PG8_SCHED;
            PG8_LDB(B1, 1, 1); PG8_STAGE(PG8_SB(1, 0), b3, voffB);
            PG8_BAR; PG8_WAIT_L(0); PG8_MMA(0, 1, At, B1); PG8_BAR;
            PG8_LDA(At, 1, 1); PG8_STAGE(PG8_SA(1, 0), a3, voffA);
            PG8_BAR; PG8_WAIT_L(0); PG8_MMA(1, 0, At, B0); PG8_BAR; PG8_SCHED;
            PG8_STAGE(PG8_SB(1, 1), b3 + hstep, voffB);
            PG8_WAIT_V(6); PG8_BAR; PG8_MMA(1, 1, At, B1); PG8_BAR;
            }
        }
        if constexpr (ALIGN_EPI) { if (wr == 0) PG8_BAR; }
        if constexpr (!Epi::AFTER_DRAIN) { E(acc, cur, wr, wc, fr, fq); S.done(cur); }
        if (!has_next) break;
#pragma unroll
        for (int a = 0; a < 2; ++a)
#pragma unroll
            for (int b = 0; b < 2; ++b)
#pragma unroll
                for (int m = 0; m < 4; ++m)
#pragma unroll
                    for (int n = 0; n < 2; ++n) acc[a][b][m][n] = (f32x4){0.f, 0.f, 0.f, 0.f};
        cur = nxt; cA = nA; cB = nB; ++ui;
        if constexpr (ALIGN_EPI) { if (wr == 1) PG8_BAR; }
    }
    PG8_WAIT_V(0);
    if constexpr (!ALIGN_EPI) { if (wr == 0) PG8_BAR; }
    PG8_BAR;
    if constexpr (Epi::AFTER_DRAIN) { E.fused(acc, cur, wr, wc, fr, fq, lds, wid, lane); S.done(cur); }
#undef PG8_SA
#undef PG8_SB
#undef PG8_STAGE
#undef PG8_LDA
#undef PG8_LDB
#undef PG8_MMA
#undef PG8_WAIT_V
#undef PG8_WAIT_L
#undef PG8_BAR
#undef PG8_SCHED
}
}

constexpr int NWAVES = 8;
constexpr int DM = 1024, NTOK = 16384, NCTX = 8192, DFF = 2816, NMODC = 6144;
constexpr float EPSN = 1e-6f;
constexpr size_t MiB = 1u << 20;
constexpr size_t PL = (size_t)NTOK * DM;
constexpr size_t WS_CTL = 0, CTL_ZERO_BYTES = 1 * MiB;
constexpr int    CW_BAR = 4096;
constexpr size_t WS_MODS = 64 * 1024;
constexpr size_t WS_LB = 208 * 1024;
constexpr size_t WS_BIAS = 256 * 1024;
constexpr size_t WS_ROWSS = 247 * MiB;
constexpr int BIAS_STRIDE = 3 * 5632, RSS_STRIDE = 4 * NTOK;
constexpr size_t WS_W_HIN = 1 * MiB, WS_W_HOUT = 11 * MiB, WS_W_SIN = 13 * MiB, WS_W_SOUT = 19 * MiB;
constexpr size_t WS_W_UP0 = 21 * MiB, WS_W_UP1 = 32 * MiB, WS_W_DN0 = 43 * MiB, WS_W_DN1 = 43 * MiB + 5767168;
constexpr size_t WS_H = 54 * MiB;
constexpr size_t WS_BIG = 86 * MiB;
constexpr size_t WS_SEGD = 246 * MiB;
constexpr size_t WS_END = 256 * MiB;
static_assert(WS_W_DN1 + 5767168 == WS_H && WS_BIG + 5 * PL * 2 == WS_SEGD, "ws map");
constexpr int RING_BYTES = 131072, XCH_OFF = RING_BYTES, XCH_BYTES = 8192, MISC_OFF = XCH_OFF + XCH_BYTES, LDS_BYTES = 147456;

#define GAS __attribute__((address_space(1)))
#define LAS __attribute__((address_space(3)))
typedef unsigned short u16;
typedef unsigned u32x4 __attribute__((ext_vector_type(4)));
typedef unsigned u32x2 __attribute__((ext_vector_type(2)));
typedef float f32x4 __attribute__((ext_vector_type(4)));
typedef short bf16x8 __attribute__((ext_vector_type(8)));
typedef __bf16 bf16x2_t __attribute__((ext_vector_type(2)));
typedef _Float16 f16x2_t __attribute__((ext_vector_type(2)));
#define LBAR() do { asm volatile("s_waitcnt lgkmcnt(0)" ::: "memory"); __builtin_amdgcn_s_barrier(); asm volatile("" ::: "memory"); } while (0)

__device__ __forceinline__ unsigned pk2(float lo, float hi) { f32x2 v = {lo, hi}; bf16x2_t b = __builtin_convertvector(v, bf16x2_t); return __builtin_bit_cast(unsigned, b); }
__device__ __forceinline__ unsigned pkh2(float lo, float hi) { f32x2 v = {lo, hi}; f16x2_t b = __builtin_convertvector(v, f16x2_t); return __builtin_bit_cast(unsigned, b); }
__device__ __forceinline__ float bflo(unsigned u) { return __builtin_bit_cast(float, u << 16); }
__device__ __forceinline__ float bfhi(unsigned u) { return __builtin_bit_cast(float, u & 0xffff0000u); }
__device__ __forceinline__ float bf1(u16 u) { return __builtin_bit_cast(float, (unsigned)u << 16); }
__device__ __forceinline__ float hlo(unsigned u) { return (float)__builtin_bit_cast(_Float16, (u16)(u & 0xffffu)); }
__device__ __forceinline__ float hhi(unsigned u) { return (float)__builtin_bit_cast(_Float16, (u16)(u >> 16)); }
__device__ __forceinline__ float frcp(float x) { return __builtin_amdgcn_rcpf(x); }
__device__ __forceinline__ float frsq(float x) { return __builtin_amdgcn_rsqf(x); }
__device__ __forceinline__ float siluf(float x) { return x * frcp(1.f + __expf(-x)); }
template <int CTRL> __device__ __forceinline__ float dppf(float v) { return __builtin_bit_cast(float, __builtin_amdgcn_update_dpp(0, __builtin_bit_cast(int, v), CTRL, 0xF, 0xF, true)); }
__device__ __forceinline__ float row16_sum(float v) { v += dppf<0xB1>(v); v += dppf<0x4E>(v); v += dppf<0x141>(v); v += dppf<0x140>(v); return v; }
__device__ __forceinline__ float wave_sum(float v) {
#pragma unroll
    for (int o = 1; o < 64; o <<= 1) v += __shfl_xor(v, o);
    return v;
}
__device__ __forceinline__ int row_group(int row) { return row < NCTX ? 0 : 1 + ((row - NCTX) >> 12); }

#define XB_TMO      128
#define XB_XCNT(j)  (256  + 64 * (j))
#define XB_XSUB(j)  (1280 + 64 * (j))
#define XB_XGEN(j)  (2304 + 64 * (j))
#define XB_TOP      3328
#define XB_TOPGEN   3392
#define XCD_BAR_WORDS 3456
#define XB_SPIN_CAP (1u << 18)

__device__ __forceinline__ unsigned xb_ld(unsigned* p)              { return __hip_atomic_load(p, __ATOMIC_RELAXED, __HIP_MEMORY_SCOPE_AGENT); }
__device__ __forceinline__ unsigned xb_add(unsigned* p, unsigned v) { return __hip_atomic_fetch_add(p, v, __ATOMIC_RELAXED, __HIP_MEMORY_SCOPE_AGENT); }
__device__ __forceinline__ unsigned xb_xcc_id() { return (unsigned)__builtin_amdgcn_s_getreg((3 << 11) | 20) & 0xFu; }
#define XB_SPIN(cond, bar) do { unsigned _sp = 0; while (cond) { __builtin_amdgcn_s_sleep(1); \
    if ((++_sp & 255u) == 0u) { if (xb_ld(&(bar)[XB_TMO])) break; if (_sp > XB_SPIN_CAP) { atomicAdd(&(bar)[XB_TMO], 1u); break; } } } } while (0)

struct XcdBarrier {
    unsigned* bar; unsigned x;
    volatile LAS unsigned* st;
};

__device__ __forceinline__ XcdBarrier xcd_barrier_post(unsigned* bar, volatile LAS unsigned* st) {
    XcdBarrier b; b.bar = bar; b.x = xb_xcc_id(); b.st = st;
    if (threadIdx.x == 0) (void)xb_add(&bar[XB_XCNT(b.x)], 1u);
    return b;
}
__device__ __forceinline__ void xcd_barrier_complete(unsigned* bar, unsigned x, unsigned& nloc, unsigned& nx) {
    const unsigned G = gridDim.x * gridDim.y * gridDim.z;
    unsigned sum, cnt, mine, sp = 0u;
    for (;;) {
        sum = 0u; cnt = 0u; mine = 0u;
#pragma unroll
        for (unsigned j = 0; j < 16; ++j) { const unsigned c = xb_ld(&bar[XB_XCNT(j)]); sum += c; cnt += (c > 0u) ? 1u : 0u; mine = (j == x) ? c : mine; }
        if (sum == G) break;
        __builtin_amdgcn_s_sleep(1);
        if ((++sp & 255u) == 0u) { if (xb_ld(&bar[XB_TMO])) break; if (sp > XB_SPIN_CAP) { atomicAdd(&bar[XB_TMO], 1u); break; } }
    }
    nloc = mine > 0u ? mine : 1u; nx = cnt > 0u ? cnt : 1u;
}

__device__ __forceinline__ void xcd_barrier(const XcdBarrier& b) {
    asm volatile("s_waitcnt vmcnt(0)" ::: "memory");
    __syncthreads();
    if (threadIdx.x == 0) {
        unsigned* bar = b.bar;
        __builtin_amdgcn_s_waitcnt(0);
        unsigned nloc = b.st[0], nx = b.st[1];
        if (nloc == 0u) { xcd_barrier_complete(bar, b.x, nloc, nx); b.st[0] = nloc; b.st[1] = nx; }
        const unsigned old = xb_add(&bar[XB_XSUB(b.x)], 1u);
        const unsigned gen = old / nloc;
        if (old + 1u == (gen + 1u) * nloc) {
            __builtin_amdgcn_fence(__ATOMIC_RELEASE, "agent");
            asm volatile("s_waitcnt vmcnt(0)" ::: "memory");
            const unsigned og = xb_add(&bar[XB_TOP], 1u);
            const unsigned tg = og / nx;
            if (og + 1u == (tg + 1u) * nx) xb_add(&bar[XB_TOPGEN], 1u);
            else XB_SPIN(xb_ld(&bar[XB_TOPGEN]) == tg, bar);
            __builtin_amdgcn_fence(__ATOMIC_ACQUIRE, "agent");
            xb_add(&bar[XB_XGEN(b.x)], 1u);
            asm volatile("s_waitcnt vmcnt(0)" ::: "memory");
        } else {
            XB_SPIN(xb_ld(&bar[XB_XGEN(b.x)]) == gen, bar);
            __builtin_amdgcn_fence(__ATOMIC_ACQUIRE, "agent");
            asm volatile("s_waitcnt vmcnt(0)" ::: "memory");
        }
    }
    __syncthreads();
}

using pg8::Unit;
__device__ __forceinline__ float rstd4(const float* p) { return frsq(((p[0] + p[NTOK]) + (p[2 * NTOK] + p[3 * NTOK])) * (1.f / DM) + EPSN); }

struct EpiProj {
    static constexpr bool PERM = true, AFTER_DRAIN = false;
    u16* planes; const float* lb; const float* rowss; const float* bias; LAS float* xch;
    __device__ __forceinline__ void operator()(const f32x4 (&acc)[2][2][4][2], const Unit& u, int wr_, int wc_, int fr_, int fq_) const {
        int fr = fr_, fq = fq_, wr = wr_, wc = wc_; asm volatile("" : "+v"(fr), "+v"(fq), "+s"(wr), "+s"(wc));
        const int plane = u.pn >> 2, colt = (u.pn & 3) * 256;
        const bool isgate = (plane == 1 || plane == 2), issilu = (plane == 0 || plane == 4);
        {
            int t = threadIdx.x; asm volatile("" : "+v"(t));
            if (t < 256) xch[1792 + t] = rstd4(rowss + u.pm * 256 + t);
            else if (t < 320) { const int c4 = (t - 256) * 4; *(LAS f32x4*)(xch + 1024 + c4) = *(const f32x4*)(bias + row_group(u.pm * 256) * 5632 + u.pn * 256 + c4); }
            else if (t < 384) { const int c4 = (t - 320) * 4; *(LAS f32x4*)(xch + 1280 + c4) = *(const f32x4*)(lb + (isgate ? (plane - 1) * 1024 : 0) + colt + c4); }
        }
        LBAR();
        u16* base = planes + (size_t)plane * PL;
        const int row0 = u.pm * 256 + wr * 64 + fr, col0 = colt + wc * 32 + 8 * fq;
        const LAS float* bl = xch + 1024 + wc * 32 + 8 * fq;
        const LAS float* ll = xch + 1280 + wc * 32 + 8 * fq;
        const LAS float* rl = xch + 1792 + wr * 64 + fr;
#pragma unroll
        for (int ai = 0; ai < 2; ++ai)
#pragma unroll
            for (int m = 0; m < 4; ++m) {
                u16* rowp = base + (size_t)(row0 + ai * 128 + m * 16) * DM + col0;
                const float rs = rl[ai * 128 + m * 16];
#pragma unroll
                for (int bj = 0; bj < 2; ++bj) {
                    float x[8];
#pragma unroll
                    for (int n = 0; n < 2; ++n) { const f32x4 bv = *(const LAS f32x4*)(bl + bj * 128 + 4 * n);
#pragma unroll
                        for (int i = 0; i < 4; ++i) x[4 * n + i] = acc[ai][bj][m][n][i] * rs + bv[i]; }
                    u32x4 w;
                    if (isgate) {
                        const f32x4 l0 = *(const LAS f32x4*)(ll + bj * 128), l1 = *(const LAS f32x4*)(ll + bj * 128 + 4);
#pragma unroll
                        for (int e = 0; e < 8; ++e) { const float l = e < 4 ? l0[e & 3] : l1[e & 3]; const float sg = frcp(1.f + __expf(-x[e])); x[e] = __logf(l + (1.f - l) * sg); }
                        w.x = pkh2(x[0], x[1]); w.y = pkh2(x[2], x[3]); w.z = pkh2(x[4], x[5]); w.w = pkh2(x[6], x[7]);
                    } else {
                        if (issilu) {
#pragma unroll
                            for (int e = 0; e < 8; ++e) x[e] = siluf(x[e]);
                        }
                        w.x = pk2(x[0], x[1]); w.y = pk2(x[2], x[3]); w.z = pk2(x[4], x[5]); w.w = pk2(x[6], x[7]);
                    }
                    *(u32x4*)(rowp + bj * 128) = w;
                }
            }
    }
};

template <int NEXT> struct EpiRes {
    static constexpr bool PERM = false, AFTER_DRAIN = false;
    const float* resA; const float* resB; float* out; const float* gate;
    u16* An; const float* nw; const float* scale; float* rowss; LAS float* xch;
    __device__ __forceinline__ void operator()(const f32x4 (&acc)[2][2][4][2], const Unit& u, int wr_, int wc_, int fr_, int fq_) const {
        int fr = fr_, fq = fq_, wr = wr_, wc = wc_; asm volatile("" : "+v"(fr), "+v"(fq), "+s"(wr), "+s"(wc));
        const int row0 = u.pm * 256 + wr * 64 + fr, col0 = u.pn * 256 + wc * 32 + 4 * fq;
        const int grp = row_group(u.pm * 256);
        const float* gp = gate + grp * NMODC + col0;
        f32x4 gv[2][2], wm[2][2];
#pragma unroll
        for (int bj = 0; bj < 2; ++bj)
#pragma unroll
            for (int n = 0; n < 2; ++n) { gv[bj][n] = *(const f32x4*)(gp + bj * 128 + n * 16);
                if (NEXT == 1) wm[bj][n] = *(const f32x4*)(nw + col0 + bj * 128 + n * 16) * (*(const f32x4*)(scale + grp * NMODC + col0 + bj * 128 + n * 16) + 1.0f); }
#pragma unroll
        for (int ai = 0; ai < 2; ++ai)
#pragma unroll
            for (int m = 0; m < 4; ++m) {
                const int row = row0 + ai * 128 + m * 16;
                const float* rp = (row < NCTX ? resA + (size_t)row * DM : resB + (size_t)(row - NCTX) * DM) + col0;
                float* op = out + (size_t)row * DM + col0;
                float ss = 0.f;
#pragma unroll
                for (int bj = 0; bj < 2; ++bj)
#pragma unroll
                    for (int n = 0; n < 2; ++n) { const f32x4 r = *(const f32x4*)(rp + bj * 128 + n * 16); const f32x4 o = r + gv[bj][n] * acc[ai][bj][m][n]; *(f32x4*)(op + bj * 128 + n * 16) = o;
                        if (NEXT >= 1) ss += (o[0] * o[0] + o[1] * o[1]) + (o[2] * o[2] + o[3] * o[3]);
                        if (NEXT == 1) { const f32x4 a = o * wm[bj][n]; u32x2 p; p.x = pk2(a[0], a[1]); p.y = pk2(a[2], a[3]); *(u32x2*)(An + (size_t)row * DM + col0 + bj * 128 + n * 16) = p; } }
                if (NEXT >= 1) { ss += __shfl_xor(ss, 16); ss += __shfl_xor(ss, 32); if (fq == 0) xch[wc * 256 + ai * 128 + wr * 64 + m * 16 + fr] = ss; }
            }
        if (NEXT >= 1) {
            LBAR();
            int t = threadIdx.x; asm volatile("" : "+v"(t));
            if (t < 256) rowss[(size_t)u.pn * NTOK + u.pm * 256 + t] = (xch[t] + xch[256 + t]) + (xch[512 + t] + xch[768 + t]);
        }
    }
};

struct EpiFfnUp {
    static constexpr bool PERM = true, AFTER_DRAIN = false;
    u16* act; const float* cw; const float* cb; LAS float* xch; const float* rowss; const float* bias;
    __device__ __forceinline__ void operator()(const f32x4 (&acc)[2][2][4][2], const Unit& u, int wr_, int wc_, int fr_, int fq_) const {
        int fr = fr_, fq = fq_, wr = wr_, wc = wc_; asm volatile("" : "+v"(fr), "+v"(fq), "+s"(wr), "+s"(wc));
        const int lane = (fq << 4) | fr;
        const bool ctx = (u.pm * 256) < NCTX;
        const int colq = wc * 32 + 8 * fq;
        const int gcol = u.pn * 128 + colq;
        {
            int t = threadIdx.x; asm volatile("" : "+v"(t));
            if (t < 256) xch[1792 + t] = rstd4(rowss + u.pm * 256 + t);
            else if (t < 448) { const int q = t - 256, v = q >> 5, c4 = (q & 31) * 4; const float* bt = bias + row_group(u.pm * 256) * 5632 + u.pn * 256;
                const f32x4 x = v < 3 ? *(const f32x4*)(cw + v * DFF + u.pn * 128 + c4) : v == 3 ? *(const f32x4*)(cb + u.pn * 128 + c4) : *(const f32x4*)(bt + (v - 4) * 128 + c4);
                *(LAS f32x4*)(xch + 1024 + v * 128 + c4) = x; }
        }
        if (fr == 0 || fr == 15) {
#pragma unroll
            for (int ai = 0; ai < 2; ++ai) {
                LAS float* p = xch + (((wr * 4 + wc) * 2 + ai) * 2 + (fr == 0 ? 0 : 1)) * 32 + 8 * fq;
                *(LAS f32x4*)p = fr == 0 ? acc[ai][0][0][0] : acc[ai][0][3][0]; *(LAS f32x4*)(p + 4) = fr == 0 ? acc[ai][0][0][1] : acc[ai][0][3][1];
            }
        }
        LBAR();
        const LAS float* cwl = xch + 1024 + colq;
        const LAS float* rl = xch + 1792;
#pragma unroll
        for (int ai = 0; ai < 2; ++ai) {
            const bool has_u = ctx && (wr == 1 || ai == 1);
            const int uai = wr == 1 ? ai : 0;
            const bool has_d = ctx && (wr == 0 || ai == 0);
            const int dai = wr == 0 ? ai : 1;
            const LAS float* pu = xch + ((((1 - wr) * 4 + wc) * 2 + uai) * 2 + 1) * 32 + 8 * fq;
            const LAS float* pd = xch + ((((1 - wr) * 4 + wc) * 2 + dai) * 2 + 0) * 32 + 8 * fq;
            const int rbase = ai * 128 + wr * 64;
            const float rsu = has_u ? rl[rbase - 1] : 0.f, rsd = has_d ? rl[rbase + 64] : 0.f;
            float rs[4];
#pragma unroll
            for (int m = 0; m < 4; ++m) rs[m] = rl[rbase + m * 16 + fr];
#define FU_A(m, n, i) (acc[ai][0][m][n][i] * rs[m] + ba[i])
#pragma unroll
            for (int m = 0; m < 4; ++m) {
                unsigned wv[4];
#pragma unroll
                for (int n = 0; n < 2; ++n) {
                    const f32x4 ba = *(const LAS f32x4*)(cwl + 4 * 128 + 4 * n), bgq = *(const LAS f32x4*)(cwl + 5 * 128 + 4 * n);
                    const f32x4 w0q = *(const LAS f32x4*)(cwl + 4 * n), w1q = *(const LAS f32x4*)(cwl + 128 + 4 * n), w2q = *(const LAS f32x4*)(cwl + 256 + 4 * n), bbq = *(const LAS f32x4*)(cwl + 384 + 4 * n);
                    float o[4];
#pragma unroll
                    for (int i = 0; i < 4; ++i) {
                        const float a = FU_A(m, n, i);
                        const float tu = (m > 0 && fr == 15) ? FU_A((m > 0 ? m - 1 : 0), n, i) : a;
                        const float td = (m < 3 && fr == 0) ? FU_A((m < 3 ? m + 1 : 3), n, i) : a;
                        float up = dppf<0x121>(tu), dn = dppf<0x12F>(td);
                        if (m == 0) { const float x = has_u ? pu[4 * n + i] * rsu + ba[i] : 0.f; if (fr == 0) up = x; }
                        if (m == 3) { const float x = has_d ? pd[4 * n + i] * rsd + ba[i] : 0.f; if (fr == 15) dn = x; }
                        const float cv = w0q[i] * up + w1q[i] * a + w2q[i] * dn + bbq[i];
                        o[i] = siluf(cv) * (acc[ai][1][m][n][i] * rs[m] + bgq[i]);
                    }
                    wv[2 * n] = pk2(o[0], o[1]); wv[2 * n + 1] = pk2(o[2], o[3]);
                }
                u32x4 w; w.x = wv[0]; w.y = wv[1]; w.z = wv[2]; w.w = wv[3];
                *(u32x4*)(act + (size_t)(u.pm * 256 + ai * 128 + wr * 64 + m * 16 + fr) * DFF + gcol) = w;
            }
#undef FU_A
        }
    }
};

struct EpiSconvIn {
    static constexpr bool PERM = true, AFTER_DRAIN = false;
    u16* cu; u16* gb; const float* rowss; const float* bias; LAS float* xch;
    __device__ __forceinline__ void operator()(const f32x4 (&acc)[2][2][4][2], const Unit& u, int wr_, int wc_, int fr_, int fq_) const {
        int fr = fr_, fq = fq_, wr = wr_, wc = wc_; asm volatile("" : "+v"(fr), "+v"(fq), "+s"(wr), "+s"(wc));
        {
            int t = threadIdx.x; asm volatile("" : "+v"(t));
            if (t < 256) xch[1792 + t] = rstd4(rowss + u.pm * 256 + t);
            else if (t < 320) { const int c4 = (t - 256) * 4; *(LAS f32x4*)(xch + 1024 + c4) = *(const f32x4*)(bias + row_group(u.pm * 256) * 5632 + u.pn * 256 + c4); }
        }
        LBAR();
        const int row0 = u.pm * 256 + wr * 64 + fr, colq = wc * 32 + 8 * fq;
        const LAS float* bl = xch + 1024 + colq;
        const LAS float* rl = xch + 1792 + wr * 64 + fr;
        const f32x4 b00 = *(const LAS f32x4*)(bl), b01 = *(const LAS f32x4*)(bl + 4), b10 = *(const LAS f32x4*)(bl + 128), b11 = *(const LAS f32x4*)(bl + 132);
#pragma unroll
        for (int ai = 0; ai < 2; ++ai)
#pragma unroll
            for (int m = 0; m < 4; ++m) {
                const size_t ro = (size_t)(row0 + ai * 128 + m * 16) * DM;
                const float rs = rl[ai * 128 + m * 16];
                if (u.pn < 8) {
                    const f32x4 p0 = (acc[ai][0][m][0] * rs + b00) * (acc[ai][1][m][0] * rs + b10), p1 = (acc[ai][0][m][1] * rs + b01) * (acc[ai][1][m][1] * rs + b11);
                    u32x4 w; w.x = pk2(p0[0], p0[1]); w.y = pk2(p0[2], p0[3]); w.z = pk2(p1[0], p1[1]); w.w = pk2(p1[2], p1[3]);
                    *(u32x4*)(cu + ro + u.pn * 128 + colq) = w;
                } else {
#pragma unroll
                    for (int bj = 0; bj < 2; ++bj) { const f32x4 p0 = acc[ai][bj][m][0] * rs + (bj ? b10 : b00), p1 = acc[ai][bj][m][1] * rs + (bj ? b11 : b01);
                        u32x4 w; w.x = pk2(p0[0], p0[1]); w.y = pk2(p0[2], p0[3]); w.z = pk2(p1[0], p1[1]); w.w = pk2(p1[2], p1[3]);
                        *(u32x4*)(gb + ro + (u.pn - 8) * 256 + bj * 128 + colq) = w; }
                }
            }
    }
};

__device__ __forceinline__ void p0_transpose_item(const float* W, int K, int N, u16* WT, int mode, LAS float* scr, int item, int lane) {
    const int nblk = N / 32, kb = item / nblk, nb = item % nblk, k0 = 64 * kb, n0 = 32 * nb;
    int d0 = n0;
    if (mode == 1) { if (n0 < DFF) d0 = (n0 >> 7) * 256 + (n0 & 127); else { const int n1 = n0 - DFF; d0 = (n1 >> 7) * 256 + 128 + (n1 & 127); } }
    else if (mode == 2) { if (n0 < 1024) d0 = 2048 + n0; else if (n0 < 2048) { const int n1 = n0 - 1024; d0 = (n1 >> 7) * 256 + (n1 & 127); } else { const int n1 = n0 - 2048; d0 = (n1 >> 7) * 256 + 128 + (n1 & 127); } }
#pragma unroll 8
    for (int i = 0; i < 32; ++i) { const int kk = 2 * i + (lane >> 5); scr[kk * 33 + (lane & 31)] = W[(size_t)(k0 + kk) * N + n0 + (lane & 31)]; }
    asm volatile("s_waitcnt lgkmcnt(0)" ::: "memory");
    const int c = lane & 7;
#pragma unroll
    for (int j = 0; j < 4; ++j) { const int n = (lane >> 3) + 8 * j; const LAS float* s = scr + (8 * c) * 33 + n;
        u32x4 o; o.x = pk2(s[0 * 33], s[1 * 33]); o.y = pk2(s[2 * 33], s[3 * 33]); o.z = pk2(s[4 * 33], s[5 * 33]); o.w = pk2(s[6 * 33], s[7 * 33]);
        *(u32x4*)(WT + (size_t)(d0 + n) * K + k0 + 8 * c) = o; }
    asm volatile("s_waitcnt lgkmcnt(0)" ::: "memory");
}

__device__ __forceinline__ void premod_rows(const float* xA, const float* xB, const float* nw, const float* scale, u16* H, float* rowss, int gw, int ngw, int lane) {
    for (int row = gw; row < NTOK; row += ngw) {
        const float* xr = (row < NCTX ? xA + (size_t)row * DM : xB + (size_t)(row - NCTX) * DM);
        const float* sg = scale + row_group(row) * NMODC;
        f32x4 v[4]; float ss = 0.f;
#pragma unroll
        for (int j = 0; j < 4; ++j) { v[j] = *(const f32x4*)(xr + 4 * lane + 256 * j); ss += (v[j][0] * v[j][0] + v[j][1] * v[j][1]) + (v[j][2] * v[j][2] + v[j][3] * v[j][3]); }
        ss = wave_sum(ss);
        if (lane < 4) rowss[(size_t)lane * NTOK + row] = lane == 0 ? ss : 0.f;
#pragma unroll
        for (int j = 0; j < 4; ++j) { const int c = 4 * lane + 256 * j;
            const f32x4 w = *(const f32x4*)(nw + c), sc = *(const f32x4*)(sg + c);
            const f32x4 o = v[j] * w * (sc + 1.0f);
            u32x2 p; p.x = pk2(o[0], o[1]); p.y = pk2(o[2], o[3]);
            *(u32x2*)(H + (size_t)row * DM + c) = p; }
    }
}

__device__ __forceinline__ void bias_row(const u16* Wt, int n, const float* shift, float* bias, int lane) {
    const u16* wr = Wt + (size_t)n * DM;
    const u32x4 w0 = *(const u32x4*)(wr + 8 * lane), w1 = *(const u32x4*)(wr + 512 + 8 * lane);
    float wv[16];
#pragma unroll
    for (int q = 0; q < 4; ++q) { wv[2 * q] = bflo(w0[q]); wv[2 * q + 1] = bfhi(w0[q]); wv[8 + 2 * q] = bflo(w1[q]); wv[8 + 2 * q + 1] = bfhi(w1[q]); }
#pragma unroll
    for (int g = 0; g < 3; ++g) {
        const float* sp = shift + g * NMODC;
        float s = 0.f;
#pragma unroll
        for (int q = 0; q < 2; ++q) { const f32x4 a = *(const f32x4*)(sp + 8 * lane + 4 * q), b = *(const f32x4*)(sp + 512 + 8 * lane + 4 * q);
#pragma unroll
            for (int i = 0; i < 4; ++i) s += wv[4 * q + i] * a[i] + wv[8 + 4 * q + i] * b[i]; }
        s = wave_sum(s);
        if (lane == 0) bias[g * 5632 + n] = s;
    }
}

__device__ __forceinline__ void final_norm_rows(float* X, const float* nw, const float* rowss, int gw, int ngw, int lane) {
    for (int row = gw; row < NTOK; row += ngw) {
        float* xr = X + (size_t)row * DM;
        const float rstd = rstd4(rowss + row);
#pragma unroll
        for (int j = 0; j < 4; ++j) { const int c = 4 * lane + 256 * j; const f32x4 w = *(const f32x4*)(nw + c); const f32x4 v = *(const f32x4*)(xr + c); *(f32x4*)(xr + c) = (v * rstd) * w; }
    }
}

__device__ __forceinline__ void mods_item(int mi, const float* c_ctx, const float* c, const float* ada_w, const float* ada_b, float* mods, LAS float* red, int tid) {
    const int wave = tid >> 6, lane = tid & 63;
    const int l = mi / 96, rem = mi % 96, cc = rem >> 2, kqr = rem & 3;
    const float* W = ada_w + (size_t)l * DM * NMODC + 256 * cc + 4 * lane;
    const int kbase = 256 * kqr + 32 * wave;
    f32x4 a0 = {0.f, 0.f, 0.f, 0.f}, a1 = a0, a2 = a0;
#pragma unroll 8
    for (int kk = 0; kk < 32; ++kk) {
        const int k = kbase + kk;
        const f32x4 w = *(const f32x4*)(W + (size_t)k * NMODC);
        const float s0 = siluf(c_ctx[k]), s1 = siluf(c[k]), s2 = siluf(c[DM + k]);
        a0 += w * s0; a1 += w * s1; a2 += w * s2;
    }
    *(LAS f32x4*)(red + (wave * 3 + 0) * 256 + 4 * lane) = a0;
    *(LAS f32x4*)(red + (wave * 3 + 1) * 256 + 4 * lane) = a1;
    *(LAS f32x4*)(red + (wave * 3 + 2) * 256 + 4 * lane) = a2;
    __syncthreads();
    for (int e = tid; e < 768; e += 512) {
        const int g = e >> 8, col = e & 255; float s = 0.f;
#pragma unroll
        for (int w = 0; w < 8; ++w) s += red[(w * 3 + g) * 256 + col];
        if (kqr == 0) s += ada_b[l * NMODC + 256 * cc + col];
        unsafeAtomicAdd(mods + (size_t)(l * 3 + g) * NMODC + 256 * cc + col, s);
    }
    __syncthreads();
}

constexpr int GL_QD = 0, GL_KI = 8704, GL_KST = 17408, GL_VT = 26624, GL_DV = 35840, GL_BUF = 36352, GL_RED = 72704, GL_STASH = 73728, GL_SROW = 256;
static_assert(GL_STASH + 256 * GL_SROW <= MISC_OFF, "scan LDS map");
__device__ __forceinline__ bf16x8 gl_frag(const LAS unsigned char* p) {
    const u32x2 a = *(const LAS u32x2*)p, b = *(const LAS u32x2*)(p + 32);
    u32x4 r; r.x = a.x; r.y = a.y; r.z = b.x; r.w = b.y; return __builtin_bit_cast(bf16x8, r);
}
__device__ __forceinline__ bf16x8 gl_pack(const f32x4& a, const f32x4& b) { u32x4 r; r.x = pk2(a[0], a[1]); r.y = pk2(a[2], a[3]); r.z = pk2(b[0], b[1]); r.w = pk2(b[2], b[3]); return __builtin_bit_cast(bf16x8, r); }

template <int MODE, int DIR>
__device__ __forceinline__ void gla_pass(LAS unsigned char* L, const u16* Qp, const u16* Lp, const u16* Vp, u16* stash, const u16* Gp, u16* outp,
                                         int row0, int h, const float* Sinit, float* Sout, float* Dout, const float* gnw, int tid_in) {
    int tid = tid_in; asm volatile("" : "+v"(tid));
    const int wave = __builtin_amdgcn_readfirstlane(tid >> 6), lane = tid & 63, fr = lane & 15, kq = lane >> 4;
    const int hoff = h * 128; constexpr int dir = DIR;
    const int tg = lane >> 3, dp = 8 * wave + (lane & 7);
    f32x4 S[8];
#pragma unroll
    for (int t = 0; t < 8; ++t)
#pragma unroll
        for (int i = 0; i < 4; ++i) S[t][i] = Sinit ? Sinit[(16 * t + 4 * kq + i) * 128 + 16 * wave + fr] : 0.f;
    float gs0 = 0.f, gs1 = 0.f;
    unsigned rqA[4], rlA[4], rvA[4], rqB[4], rlB[4], rvB[4]; u16 rgA[2][4], rgB[2][4];
#define GLA_LOAD(ci) do { _Pragma("unroll") for (int j = 0; j < 4; ++j) { const int tau = 32 * (ci) + 4 * tg + j; const size_t ro = (size_t)(row0 + (dir ? 255 - tau : tau)) * DM + hoff + 2 * dp; \
        if (MODE != 0) rq[j] = *(const unsigned*)(Qp + ro); rl[j] = *(const unsigned*)(Lp + ro); rv[j] = *(const unsigned*)(Vp + ro); } \
        if (MODE == 2) { _Pragma("unroll") for (int ct = 0; ct < 2; ++ct) _Pragma("unroll") for (int i = 0; i < 4; ++i) { const int tau = 32 * (ci) + 16 * ct + 4 * kq + i; \
            const size_t ro = (size_t)(row0 + (dir ? 255 - tau : tau)) * DM + hoff + 16 * wave + fr; rg_[ct][i] = Gp[ro]; } } } while (0)
    { unsigned (&rq)[4] = rqA, (&rl)[4] = rlA, (&rv)[4] = rvA; u16 (&rg_)[2][4] = rgA; GLA_LOAD(0); }
    { unsigned (&rq)[4] = rqB, (&rl)[4] = rlB, (&rv)[4] = rvB; u16 (&rg_)[2][4] = rgB; GLA_LOAD(1); }
    auto step = [&](const int ci, unsigned (&rq)[4], unsigned (&rl)[4], unsigned (&rv)[4], u16 (&rg_)[2][4], LAS unsigned char* B) __attribute__((always_inline)) {
        float q0[4], q1[4], c0[4], c1[4], k0[4], k1[4]; unsigned vc[4];
#pragma unroll
        for (int j = 0; j < 4; ++j) { if (MODE != 0) { q0[j] = bflo(rq[j]); q1[j] = bfhi(rq[j]); } else { q0[j] = 0.f; q1[j] = 0.f; }
            const float l0 = hlo(rl[j]), l1 = hhi(rl[j]); k0[j] = 1.f - __expf(l0); k1[j] = 1.f - __expf(l1);
            c0[j] = l0 + (j ? c0[j ? j - 1 : 0] : 0.f); c1[j] = l1 + (j ? c1[j ? j - 1 : 0] : 0.f); vc[j] = rv[j]; }
        float gg_[2][4];
        if (MODE == 2) {
#pragma unroll
            for (int ct = 0; ct < 2; ++ct)
#pragma unroll
                for (int i = 0; i < 4; ++i) gg_[ct][i] = bf1(rg_[ct][i]);
        }
        { const int cn = ci + 2 < 8 ? ci + 2 : 7; GLA_LOAD(cn); }
        float in0 = c0[3], in1 = c1[3];
        { float t0 = __shfl_up(in0, 8), t1 = __shfl_up(in1, 8); if (tg >= 1) { in0 += t0; in1 += t1; }
          t0 = __shfl_up(in0, 16); t1 = __shfl_up(in1, 16); if (tg >= 2) { in0 += t0; in1 += t1; }
          t0 = __shfl_up(in0, 32); t1 = __shfl_up(in1, 32); if (tg >= 4) { in0 += t0; in1 += t1; } }
        const float pre0 = in0 - c0[3], pre1 = in1 - c1[3];
        const float gl0 = __shfl(in0, 56 + (lane & 7)), gl1 = __shfl(in1, 56 + (lane & 7));
        float ks0[4], ks1[4]; const float egl0 = __expf(gl0), egl1 = __expf(gl1);
#pragma unroll
        for (int j = 0; j < 4; ++j) {
            const float g0 = pre0 + c0[j], g1 = pre1 + c1[j];
            const float ki0 = k0[j] * __expf(-g0), ki1 = k1[j] * __expf(-g1);
            ks0[j] = ki0 * egl0; ks1[j] = ki1 * egl1;
            if (MODE != 0) {
                const int s = 4 * tg + j;
                *(LAS unsigned*)(B + GL_QD + s * 272 + 4 * dp) = pk2(q0[j] * __expf(g0), q1[j] * __expf(g1));
                *(LAS unsigned*)(B + GL_KI + s * 272 + 4 * dp) = pk2(ki0, ki1);
            }
        }
        { u32x2 a, b; a.x = pk2(ks0[0], ks0[1]); a.y = pk2(ks0[2], ks0[3]); b.x = pk2(ks1[0], ks1[1]); b.y = pk2(ks1[2], ks1[3]);
          *(LAS u32x2*)(B + GL_KST + (2 * dp) * 72 + 8 * tg) = a; *(LAS u32x2*)(B + GL_KST + (2 * dp + 1) * 72 + 8 * tg) = b;
          u32x2 c, d; c.x = (vc[0] & 0xffffu) | (vc[1] << 16); c.y = (vc[2] & 0xffffu) | (vc[3] << 16); d.x = (vc[0] >> 16) | (vc[1] & 0xffff0000u); d.y = (vc[2] >> 16) | (vc[3] & 0xffff0000u);
          *(LAS u32x2*)(B + GL_VT + (2 * dp) * 72 + 8 * tg) = c; *(LAS u32x2*)(B + GL_VT + (2 * dp + 1) * 72 + 8 * tg) = d; }
        if (tg == 0) { *(LAS f32x2*)(B + GL_DV + 8 * dp) = (f32x2){egl0, egl1}; gs0 += gl0; gs1 += gl1; }
        LBAR();
        const bf16x8 vb = gl_frag(B + GL_VT + (16 * wave + fr) * 72 + 8 * kq);
        f32x4 o[2] = {{0.f, 0.f, 0.f, 0.f}, {0.f, 0.f, 0.f, 0.f}};
        if (MODE != 0) {
            bf16x8 qf[2][4];
#pragma unroll
            for (int ct = 0; ct < 2; ++ct)
#pragma unroll
                for (int p = 0; p < 4; ++p) qf[ct][p] = gl_frag(B + GL_QD + (16 * ct + fr) * 272 + (32 * p + 4 * kq) * 2);
#pragma unroll
            for (int p = 0; p < 4; ++p) { const bf16x8 sb = gl_pack(S[2 * p], S[2 * p + 1]);
                o[0] = __builtin_amdgcn_mfma_f32_16x16x32_bf16(qf[0][p], sb, o[0], 0, 0, 0); o[1] = __builtin_amdgcn_mfma_f32_16x16x32_bf16(qf[1][p], sb, o[1], 0, 0, 0); }
            f32x4 s00 = {0.f, 0.f, 0.f, 0.f}, s01 = s00, s11 = s00;
#pragma unroll
            for (int p = 0; p < 4; ++p) {
                const bf16x8 kf0 = gl_frag(B + GL_KI + fr * 272 + (32 * p + 4 * kq) * 2), kf1 = gl_frag(B + GL_KI + (16 + fr) * 272 + (32 * p + 4 * kq) * 2);
                s00 = __builtin_amdgcn_mfma_f32_16x16x32_bf16(kf0, qf[0][p], s00, 0, 0, 0);
                s01 = __builtin_amdgcn_mfma_f32_16x16x32_bf16(kf0, qf[1][p], s01, 0, 0, 0);
                s11 = __builtin_amdgcn_mfma_f32_16x16x32_bf16(kf1, qf[1][p], s11, 0, 0, 0);
            }
#pragma unroll
            for (int i = 0; i < 4; ++i) if (4 * kq + i > fr) { s00[i] = 0.f; s11[i] = 0.f; }
            const f32x4 z4 = {0.f, 0.f, 0.f, 0.f};
            const bf16x8 pa0 = gl_pack(s00, z4), pa1 = gl_pack(s01, s11);
            o[0] = __builtin_amdgcn_mfma_f32_16x16x32_bf16(pa0, vb, o[0], 0, 0, 0); o[1] = __builtin_amdgcn_mfma_f32_16x16x32_bf16(pa1, vb, o[1], 0, 0, 0);
        }
#pragma unroll
        for (int t = 0; t < 8; ++t) {
            const f32x4 dv = *(const LAS f32x4*)(B + GL_DV + (16 * t + 4 * kq) * 4);
            const bf16x8 ka = gl_frag(B + GL_KST + (16 * t + fr) * 72 + 8 * kq);
            S[t] = S[t] * dv;
            S[t] = __builtin_amdgcn_mfma_f32_16x16x32_bf16(ka, vb, S[t], 0, 0, 0);
        }
        if (MODE == 1) {
#pragma unroll
            for (int ct = 0; ct < 2; ++ct)
#pragma unroll
                for (int i = 0; i < 4; ++i) { const int tau = 32 * ci + 16 * ct + 4 * kq + i, tok = dir ? 255 - tau : tau;
                    *(LAS u16*)(L + GL_STASH + tok * GL_SROW + (16 * wave + fr) * 2) = (u16)(pk2(o[ct][i], 0.f) & 0xffffu); }
        }
        if (MODE == 2) {
            float ov[2][4], ssv[2][4];
#pragma unroll
            for (int ct = 0; ct < 2; ++ct)
#pragma unroll
                for (int i = 0; i < 4; ++i) { const int tau = 32 * ci + 16 * ct + 4 * kq + i, tok = dir ? 255 - tau : tau;
                    ov[ct][i] = o[ct][i] + bf1(*(const LAS u16*)(L + GL_STASH + tok * GL_SROW + (16 * wave + fr) * 2));
                    ssv[ct][i] = row16_sum(ov[ct][i] * ov[ct][i]); }
            if (fr == 0) {
#pragma unroll
                for (int ct = 0; ct < 2; ++ct) *(LAS f32x4*)(L + GL_RED + (wave * 32 + 16 * ct + 4 * kq) * 4) = (f32x4){ssv[ct][0], ssv[ct][1], ssv[ct][2], ssv[ct][3]};
            }
            const float gw_ = gnw[16 * wave + fr];
            LBAR();
#pragma unroll
            for (int ct = 0; ct < 2; ++ct) {
                f32x4 tot = {0.f, 0.f, 0.f, 0.f};
#pragma unroll
                for (int w = 0; w < 8; ++w) tot += *(const LAS f32x4*)(L + GL_RED + (w * 32 + 16 * ct + 4 * kq) * 4);
#pragma unroll
                for (int i = 0; i < 4; ++i) { const int tau = 32 * ci + 16 * ct + 4 * kq + i, tok = dir ? 255 - tau : tau;
                    const float rstd = frsq(tot[i] * (1.f / 128.f) + EPSN);
                    *(LAS u16*)(L + GL_STASH + tok * GL_SROW + (16 * wave + fr) * 2) = (u16)(pk2(ov[ct][i] * rstd * gw_ * gg_[ct][i], 0.f) & 0xffffu); }
            }
        }
    };
#pragma unroll 1
    for (int c2 = 0; c2 < 8; c2 += 2) { step(c2, rqA, rlA, rvA, rgA, L); step(c2 + 1, rqB, rlB, rvB, rgB, L + GL_BUF); }
#undef GLA_LOAD
    if (MODE == 2 && outp != nullptr) {
        LBAR();
#pragma unroll
        for (int k = 0; k < 8; ++k) { const int pc = tid + 512 * k, row = pc >> 4, c16 = pc & 15;
            const u32x4 v = *(const LAS u32x4*)(L + GL_STASH + row * GL_SROW + c16 * 16);
            *(u32x4*)(outp + (size_t)(row0 + row) * DM + hoff + c16 * 8) = v; }
    }
    if (Sout) {
#pragma unroll
        for (int t = 0; t < 8; ++t)
#pragma unroll
            for (int i = 0; i < 4; ++i) Sout[(16 * t + 4 * kq + i) * 128 + 16 * wave + fr] = S[t][i];
    }
    if (MODE == 0 && tg == 0) { Dout[2 * dp] = __expf(gs0); Dout[2 * dp + 1] = __expf(gs1); }
    asm volatile("s_waitcnt vmcnt(0)" ::: "memory");
    __syncthreads();
}

__device__ __forceinline__ void sconv_rows(const u16* cu, const u16* gb, const float* cw, const float* cb, u16* A2, int gtid, int ngt) {
    for (int it = gtid; it < NTOK * 128; it += ngt) {
        const int row = it >> 7, c = (it & 127) * 8;
        bool hp, hn; int dlt;
        if (row < NCTX) { dlt = 1; const int t = row & 255; hp = t > 0; hn = t < 255; }
        else { dlt = 64; const int t = (row - NCTX) & 4095; hp = t >= 64; hn = t < 4096 - 64; }
        const u32x4 z = {0u, 0u, 0u, 0u};
        const u32x4 m = *(const u32x4*)(cu + (size_t)row * DM + c);
        const u32x4 p = hp ? *(const u32x4*)(cu + (size_t)(row - dlt) * DM + c) : z;
        const u32x4 n = hn ? *(const u32x4*)(cu + (size_t)(row + dlt) * DM + c) : z;
        const u32x4 g = *(const u32x4*)(gb + (size_t)row * DM + c);
        float w0[8], w1[8], w2[8], bb[8];
#pragma unroll
        for (int q = 0; q < 2; ++q) { const f32x4 a = *(const f32x4*)(cw + c + 4 * q), b = *(const f32x4*)(cw + DM + c + 4 * q), d = *(const f32x4*)(cw + 2 * DM + c + 4 * q), e = *(const f32x4*)(cb + c + 4 * q);
#pragma unroll
            for (int i = 0; i < 4; ++i) { w0[4 * q + i] = a[i]; w1[4 * q + i] = b[i]; w2[4 * q + i] = d[i]; bb[4 * q + i] = e[i]; } }
        u32x4 o;
#pragma unroll
        for (int q = 0; q < 4; ++q) {
            const float zl = w0[2 * q] * bflo(p[q]) + w1[2 * q] * bflo(m[q]) + w2[2 * q] * bflo(n[q]) + bb[2 * q];
            const float zh = w0[2 * q + 1] * bfhi(p[q]) + w1[2 * q + 1] * bfhi(m[q]) + w2[2 * q + 1] * bfhi(n[q]) + bb[2 * q + 1];
            o[q] = pk2(zl * bflo(g[q]), zh * bfhi(g[q]));
        }
        *(u32x4*)(A2 + (size_t)row * DM + c) = o;
    }
}

#ifndef PROBE
#define PROBE 0
#endif
#ifndef PH
#define PH 0x7fff
#endif
struct Args { const float* in[22]; float* out; unsigned char* ws; };
enum { I_XP = 0, I_XS, I_STATE, I_C, I_CCTX, I_ADAW, I_ADAB, I_NMIX, I_NFFN, I_HWIN, I_HLB, I_HGN, I_HWOUT, I_SWIN, I_SCW, I_SCB, I_SWOUT, I_FUP, I_FCW, I_FCB, I_FDN, I_FNW };

#define KAS __attribute__((address_space(4)))
#define GRID_BAR() do { const KAS Args* bp_ = (const KAS Args*)__builtin_amdgcn_kernarg_segment_ptr(); asm volatile("" : "+s"(bp_)); \
    XcdBarrier b_; b_.bar = (unsigned*)(bp_->ws + WS_CTL) + CW_BAR; b_.x = xb_xcc_id(); b_.st = (volatile LAS unsigned*)((LAS unsigned char*)lds + MISC_OFF) + 8; xcd_barrier(b_); } while (0)
#define PHASE_ENV() const KAS Args* ap_ = (const KAS Args*)__builtin_amdgcn_kernarg_segment_ptr(); asm volatile("" : "+s"(ap_)); \
    unsigned char* ws = ap_->ws; float* out = ap_->out; (void)ws; (void)out; \
    int tid_ = threadIdx.x; asm volatile("" : "+v"(tid_)); const int tid = tid_, lane = tid & 63, wave = __builtin_amdgcn_readfirstlane(tid >> 6); \
    const int G = gridDim.x, blk = blockIdx.x, gw = blk * NWAVES + wave, NGW = G * NWAVES; (void)lane; (void)gw; (void)NGW; \
    float* mods = (float*)(ws + WS_MODS); (void)mods
#define IN(k) (ap_->in[k])

__global__ void __launch_bounds__(NWAVES * 64, 2) hgrn_dit_fwd(Args args) {
    extern __shared__ __attribute__((aligned(16))) unsigned char lds[];
    LAS unsigned char* L = (LAS unsigned char*)lds;
    volatile LAS unsigned* MISC = (volatile LAS unsigned*)(L + MISC_OFF);
    for (int u = threadIdx.x; u < 32; u += NWAVES * 64) MISC[u] = 0u;
    __syncthreads();
    (void)xcd_barrier_post((unsigned*)(args.ws + WS_CTL) + CW_BAR, MISC + 8);

    {
        PHASE_ENV();
        if (PH & 1) if (blk < 192) mods_item(blk, IN(I_CCTX), IN(I_C), IN(I_ADAW), IN(I_ADAB), mods, (LAS float*)L, tid);
        if (blk == G - 1) {
            const float* lbnd = IN(I_HLB);
            float* lbv = (float*)(ws + WS_LB);
            for (int e = tid; e < 2048; e += NWAVES * 64) { const int dir = e >> 10, i = e & 1023; lbv[e] = frcp(1.f + __expf(lbnd[dir * 2048 + 1024 + i] - lbnd[dir * 2048 + i])); }
        }
        LAS float* scr = (LAS float*)(L + wave * 16384);
        constexpr int I_A = (DM / 64) * (5120 / 32), I_B = (DM / 64) * (DM / 32), I_C2 = (DM / 64) * (3072 / 32), I_U = (DM / 64) * (2 * DFF / 32), I_D = (DFF / 64) * (DM / 32);
        constexpr int NITEMS = I_A + I_B + I_C2 + I_B + 2 * I_U + 2 * I_D;
        if (PH & 2) for (int it = gw; it < NITEMS; it += NGW) {
            int r = it;
            if (r < I_A) { p0_transpose_item(IN(I_HWIN), DM, 5120, (u16*)(ws + WS_W_HIN), 0, scr, r, lane); continue; } r -= I_A;
            if (r < I_B) { p0_transpose_item(IN(I_HWOUT), DM, DM, (u16*)(ws + WS_W_HOUT), 0, scr, r, lane); continue; } r -= I_B;
            if (r < I_C2) { p0_transpose_item(IN(I_SWIN), DM, 3072, (u16*)(ws + WS_W_SIN), 2, scr, r, lane); continue; } r -= I_C2;
            if (r < I_B) { p0_transpose_item(IN(I_SWOUT), DM, DM, (u16*)(ws + WS_W_SOUT), 0, scr, r, lane); continue; } r -= I_B;
            if (r < I_U) { p0_transpose_item(IN(I_FUP), DM, 2 * DFF, (u16*)(ws + WS_W_UP0), 1, scr, r, lane); continue; } r -= I_U;
            if (r < I_U) { p0_transpose_item(IN(I_FUP) + (size_t)DM * 2 * DFF, DM, 2 * DFF, (u16*)(ws + WS_W_UP1), 1, scr, r, lane); continue; } r -= I_U;
            if (r < I_D) { p0_transpose_item(IN(I_FDN), DFF, DM, (u16*)(ws + WS_W_DN0), 0, scr, r, lane); continue; } r -= I_D;
            p0_transpose_item(IN(I_FDN) + (size_t)DFF * DM, DFF, DM, (u16*)(ws + WS_W_DN1), 0, scr, r, lane);
        }
    }
    GRID_BAR();

    if (PH & 4) { PHASE_ENV(); float* rowss = (float*)(ws + WS_ROWSS); float* bias = (float*)(ws + WS_BIAS);
        premod_rows(IN(I_XP), IN(I_XS), IN(I_NMIX), mods + 1 * 1024, (u16*)(ws + WS_H), rowss, gw, NGW, lane);
        for (int r = gw; r < 5120 + 5632 + 3072 + 5632; r += NGW) {
            if (r < 5120) bias_row((const u16*)(ws + WS_W_HIN), r, mods + 0 * 1024, bias, lane);
            else if (r < 5120 + 5632) bias_row((const u16*)(ws + WS_W_UP0), r - 5120, mods + 3 * 1024, bias + BIAS_STRIDE, lane);
            else if (r < 5120 + 5632 + 3072) bias_row((const u16*)(ws + WS_W_SIN), r - 5120 - 5632, mods + 3 * NMODC + 0 * 1024, bias + 2 * BIAS_STRIDE, lane);
            else bias_row((const u16*)(ws + WS_W_UP1), r - 5120 - 5632 - 3072, mods + 3 * NMODC + 3 * 1024, bias + 3 * BIAS_STRIDE, lane);
        }
    }
    GRID_BAR();

#if PROBE == 3
    { PHASE_ENV();
        LAS float* scr = (LAS float*)(L + wave * 16384);
        constexpr int I_A = (DM / 64) * (5120 / 32), I_B = (DM / 64) * (DM / 32), I_C2 = (DM / 64) * (3072 / 32), I_U = (DM / 64) * (2 * DFF / 32), I_D = (DFF / 64) * (DM / 32);
        constexpr int NITEMS = I_A + I_B + I_C2 + I_B + 2 * I_U + 2 * I_D;
        if (PH & 2) for (int it = gw; it < NITEMS; it += NGW) {
            int r = it;
            if (r < I_A) { p0_transpose_item(IN(I_HWIN), DM, 5120, (u16*)(ws + WS_W_HIN), 0, scr, r, lane); continue; } r -= I_A;
            if (r < I_B) { p0_transpose_item(IN(I_HWOUT), DM, DM, (u16*)(ws + WS_W_HOUT), 0, scr, r, lane); continue; } r -= I_B;
            if (r < I_C2) { p0_transpose_item(IN(I_SWIN), DM, 3072, (u16*)(ws + WS_W_SIN), 2, scr, r, lane); continue; } r -= I_C2;
            if (r < I_B) { p0_transpose_item(IN(I_SWOUT), DM, DM, (u16*)(ws + WS_W_SOUT), 0, scr, r, lane); continue; } r -= I_B;
            if (r < I_U) { p0_transpose_item(IN(I_FUP), DM, 2 * DFF, (u16*)(ws + WS_W_UP0), 1, scr, r, lane); continue; } r -= I_U;
            if (r < I_U) { p0_transpose_item(IN(I_FUP) + (size_t)DM * 2 * DFF, DM, 2 * DFF, (u16*)(ws + WS_W_UP1), 1, scr, r, lane); continue; } r -= I_U;
            if (r < I_D) { p0_transpose_item(IN(I_FDN), DFF, DM, (u16*)(ws + WS_W_DN0), 0, scr, r, lane); continue; } r -= I_D;
            p0_transpose_item(IN(I_FDN) + (size_t)DFF * DM, DFF, DM, (u16*)(ws + WS_W_DN1), 0, scr, r, lane);
        }
    }
    GRID_BAR();
    if (PH & 4) { PHASE_ENV(); float* rowss = (float*)(ws + WS_ROWSS); float* bias = (float*)(ws + WS_BIAS);
        premod_rows(IN(I_XP), IN(I_XS), IN(I_NMIX), mods + 1 * 1024, (u16*)(ws + WS_H), rowss, gw, NGW, lane);
        for (int r = gw; r < 5120 + 5632 + 3072 + 5632; r += NGW) {
            if (r < 5120) bias_row((const u16*)(ws + WS_W_HIN), r, mods + 0 * 1024, bias, lane);
            else if (r < 5120 + 5632) bias_row((const u16*)(ws + WS_W_UP0), r - 5120, mods + 3 * 1024, bias + BIAS_STRIDE, lane);
            else if (r < 5120 + 5632 + 3072) bias_row((const u16*)(ws + WS_W_SIN), r - 5120 - 5632, mods + 3 * NMODC + 0 * 1024, bias + 2 * BIAS_STRIDE, lane);
            else bias_row((const u16*)(ws + WS_W_UP1), r - 5120 - 5632 - 3072, mods + 3 * NMODC + 3 * 1024, bias + 3 * BIAS_STRIDE, lane);
        }
    }
    GRID_BAR();

#endif
#pragma unroll
    for (int layer = 0; layer < 2; ++layer) {
        if (layer == 0) {
            for (int rp2_ = 0; rp2_ < (PROBE == 2 ? 2 : 1); ++rp2_) {
            if (PH & 8) { PHASE_ENV(); pg8::Gemm g{(const u16*)(ws + WS_H), (const u16*)(ws + WS_W_HIN), NTOK, 5120, DM}; pg8::StaticOrder S; S.init(NTOK, 5120, G, blk);
              EpiProj E{(u16*)(ws + WS_BIG), (const float*)(ws + WS_LB), (const float*)(ws + WS_ROWSS), (const float*)(ws + WS_BIAS), (LAS float*)(L + XCH_OFF)};
              pg8::gemm_phase<EpiProj, pg8::StaticOrder, true, true>(L, g, S, E); }
            GRID_BAR();
            }
            for (int rp6_ = (PROBE == 6 ? 0 : 1); rp6_ < 2; ++rp6_) {
            for (int rp4_ = 0; rp4_ < (PROBE == 4 ? 2 : 1); ++rp4_) { if (rp4_) GRID_BAR();
            if (PH & 16) for (int idx = blockIdx.x; idx < 512; idx += gridDim.x) {
                PHASE_ENV(); u16* BIG = (u16*)(ws + WS_BIG); float* SEGKV = (float*)(ws + WS_H); float* SEGD = (float*)(ws + WS_SEGD);
                const int b = idx >> 8, h = (idx >> 5) & 7, dir = (idx >> 4) & 1, seg = idx & 15;
                if ((dir == 0 && seg == 15) || (dir == 1 && seg == 0)) continue;
                if (dir == 0) gla_pass<0, 0>(L, nullptr, BIG + 1 * PL, BIG + 3 * PL, nullptr, nullptr, nullptr, NCTX + b * 4096 + seg * 256, h, nullptr, SEGKV + (size_t)idx * 16384, SEGD + (size_t)idx * 128, nullptr, tid);
                else gla_pass<0, 1>(L, nullptr, BIG + 2 * PL, BIG + 3 * PL, nullptr, nullptr, nullptr, NCTX + b * 4096 + seg * 256, h, nullptr, SEGKV + (size_t)idx * 16384, SEGD + (size_t)idx * 128, nullptr, tid);
            }
            }
            GRID_BAR();
            if (PH & 32) for (int w = blockIdx.x; w < 256; w += gridDim.x) {
                PHASE_ENV(); float* SEGKV = (float*)(ws + WS_H); const float* SEGD = (const float*)(ws + WS_SEGD);
                const int chain = w >> 3, part = w & 7, e4 = (part * 512 + tid) * 4, d = e4 >> 7;
                const int dir = chain & 1, bh = chain >> 1;
                const int b = bh >> 3, h = bh & 7;
                f32x4 S = *(const f32x4*)(IN(I_STATE) + ((size_t)((b * 2 + dir) * 8 + h)) * 16384 + e4);
                f32x4 kv[15]; float dd[15];
#pragma unroll
                for (int k = 0; k < 15; ++k) { const int seg = dir ? 15 - k : k; kv[k] = *(const f32x4*)(SEGKV + ((size_t)chain * 16 + seg) * 16384 + e4); dd[k] = SEGD[((size_t)chain * 16 + seg) * 128 + d]; }
#pragma unroll
                for (int k = 0; k < 16; ++k) { const int seg = dir ? 15 - k : k; *(f32x4*)(SEGKV + ((size_t)chain * 16 + seg) * 16384 + e4) = S; if (k < 15) S = S * dd[k < 15 ? k : 0] + kv[k < 15 ? k : 0]; }
            }
            GRID_BAR();
            if (PH & 64) for (int it = blockIdx.x; it < 512; it += gridDim.x) {
                PHASE_ENV(); u16* BIG = (u16*)(ws + WS_BIG); const float* SEGKV = (const float*)(ws + WS_H);
                int row0, h; const float *sif = nullptr, *sib = nullptr; float *sof = nullptr, *sob = nullptr;
                if (it < 256) { const int b = it >> 3; h = it & 7; row0 = b * 256;
                    sof = out + (size_t)NTOK * DM + ((size_t)((b * 2 + 0) * 8 + h)) * 16384; sob = out + (size_t)NTOK * DM + ((size_t)((b * 2 + 1) * 8 + h)) * 16384; }
                else { const int idx = it - 256, b = idx >> 7, seg = idx & 15; h = (idx >> 4) & 7; row0 = NCTX + b * 4096 + seg * 256;
                    sif = SEGKV + ((size_t)(((b * 8 + h) * 2 + 0) * 16 + seg)) * 16384; sib = SEGKV + ((size_t)(((b * 8 + h) * 2 + 1) * 16 + seg)) * 16384; }
                gla_pass<1, 0>(L, BIG, BIG + PL, BIG + 3 * PL, nullptr, nullptr, nullptr, row0, h, sif, sof, nullptr, nullptr, tid);
                gla_pass<2, 1>(L, BIG, BIG + 2 * PL, BIG + 3 * PL, nullptr, BIG + 4 * PL, rp6_ ? BIG : (u16*)nullptr, row0, h, sib, sob, nullptr, IN(I_HGN), tid);
            }
            GRID_BAR();
            }
#if PROBE == 1
            {
    if (PH & 4) { PHASE_ENV(); float* rowss = (float*)(ws + WS_ROWSS); float* bias = (float*)(ws + WS_BIAS);
        premod_rows(IN(I_XP), IN(I_XS), IN(I_NMIX), mods + 1 * 1024, (u16*)(ws + WS_H), rowss, gw, NGW, lane);
        for (int r = gw; r < 5120 + 5632 + 3072 + 5632; r += NGW) {
            if (r < 5120) bias_row((const u16*)(ws + WS_W_HIN), r, mods + 0 * 1024, bias, lane);
            else if (r < 5120 + 5632) bias_row((const u16*)(ws + WS_W_UP0), r - 5120, mods + 3 * 1024, bias + BIAS_STRIDE, lane);
            else if (r < 5120 + 5632 + 3072) bias_row((const u16*)(ws + WS_W_SIN), r - 5120 - 5632, mods + 3 * NMODC + 0 * 1024, bias + 2 * BIAS_STRIDE, lane);
            else bias_row((const u16*)(ws + WS_W_UP1), r - 5120 - 5632 - 3072, mods + 3 * NMODC + 3 * 1024, bias + 3 * BIAS_STRIDE, lane);
        }
    }
    GRID_BAR();

            for (int rp2_ = 0; rp2_ < (PROBE == 2 ? 2 : 1); ++rp2_) {
            if (PH & 8) { PHASE_ENV(); pg8::Gemm g{(const u16*)(ws + WS_H), (const u16*)(ws + WS_W_HIN), NTOK, 5120, DM}; pg8::StaticOrder S; S.init(NTOK, 5120, G, blk);
              EpiProj E{(u16*)(ws + WS_BIG), (const float*)(ws + WS_LB), (const float*)(ws + WS_ROWSS), (const float*)(ws + WS_BIAS), (LAS float*)(L + XCH_OFF)};
              pg8::gemm_phase<EpiProj, pg8::StaticOrder, true, true>(L, g, S, E); }
            GRID_BAR();
            }
            for (int rp6_ = (PROBE == 6 ? 0 : 1); rp6_ < 2; ++rp6_) {
            for (int rp4_ = 0; rp4_ < (PROBE == 4 ? 2 : 1); ++rp4_) { if (rp4_) GRID_BAR();
            if (PH & 16) for (int idx = blockIdx.x; idx < 512; idx += gridDim.x) {
                PHASE_ENV(); u16* BIG = (u16*)(ws + WS_BIG); float* SEGKV = (float*)(ws + WS_H); float* SEGD = (float*)(ws + WS_SEGD);
                const int b = idx >> 8, h = (idx >> 5) & 7, dir = (idx >> 4) & 1, seg = idx & 15;
                if ((dir == 0 && seg == 15) || (dir == 1 && seg == 0)) continue;
                if (dir == 0) gla_pass<0, 0>(L, nullptr, BIG + 1 * PL, BIG + 3 * PL, nullptr, nullptr, nullptr, NCTX + b * 4096 + seg * 256, h, nullptr, SEGKV + (size_t)idx * 16384, SEGD + (size_t)idx * 128, nullptr, tid);
                else gla_pass<0, 1>(L, nullptr, BIG + 2 * PL, BIG + 3 * PL, nullptr, nullptr, nullptr, NCTX + b * 4096 + seg * 256, h, nullptr, SEGKV + (size_t)idx * 16384, SEGD + (size_t)idx * 128, nullptr, tid);
            }
            }
            GRID_BAR();
            if (PH & 32) for (int w = blockIdx.x; w < 256; w += gridDim.x) {
                PHASE_ENV(); float* SEGKV = (float*)(ws + WS_H); const float* SEGD = (const float*)(ws + WS_SEGD);
                const int chain = w >> 3, part = w & 7, e4 = (part * 512 + tid) * 4, d = e4 >> 7;
                const int dir = chain & 1, bh = chain >> 1;
                const int b = bh >> 3, h = bh & 7;
                f32x4 S = *(const f32x4*)(IN(I_STATE) + ((size_t)((b * 2 + dir) * 8 + h)) * 16384 + e4);
                f32x4 kv[15]; float dd[15];
#pragma unroll
                for (int k = 0; k < 15; ++k) { const int seg = dir ? 15 - k : k; kv[k] = *(const f32x4*)(SEGKV + ((size_t)chain * 16 + seg) * 16384 + e4); dd[k] = SEGD[((size_t)chain * 16 + seg) * 128 + d]; }
#pragma unroll
                for (int k = 0; k < 16; ++k) { const int seg = dir ? 15 - k : k; *(f32x4*)(SEGKV + ((size_t)chain * 16 + seg) * 16384 + e4) = S; if (k < 15) S = S * dd[k < 15 ? k : 0] + kv[k < 15 ? k : 0]; }
            }
            GRID_BAR();
            if (PH & 64) for (int it = blockIdx.x; it < 512; it += gridDim.x) {
                PHASE_ENV(); u16* BIG = (u16*)(ws + WS_BIG); const float* SEGKV = (const float*)(ws + WS_H);
                int row0, h; const float *sif = nullptr, *sib = nullptr; float *sof = nullptr, *sob = nullptr;
                if (it < 256) { const int b = it >> 3; h = it & 7; row0 = b * 256;
                    sof = out + (size_t)NTOK * DM + ((size_t)((b * 2 + 0) * 8 + h)) * 16384; sob = out + (size_t)NTOK * DM + ((size_t)((b * 2 + 1) * 8 + h)) * 16384; }
                else { const int idx = it - 256, b = idx >> 7, seg = idx & 15; h = (idx >> 4) & 7; row0 = NCTX + b * 4096 + seg * 256;
                    sif = SEGKV + ((size_t)(((b * 8 + h) * 2 + 0) * 16 + seg)) * 16384; sib = SEGKV + ((size_t)(((b * 8 + h) * 2 + 1) * 16 + seg)) * 16384; }
                gla_pass<1, 0>(L, BIG, BIG + PL, BIG + 3 * PL, nullptr, nullptr, nullptr, row0, h, sif, sof, nullptr, nullptr, tid);
                gla_pass<2, 1>(L, BIG, BIG + 2 * PL, BIG + 3 * PL, nullptr, BIG + 4 * PL, rp6_ ? BIG : (u16*)nullptr, row0, h, sib, sob, nullptr, IN(I_HGN), tid);
            }
            GRID_BAR();
            }
            }
#endif
            for (int rp7_ = (PROBE == 7 ? 0 : 1); rp7_ < 2; ++rp7_) { if (PROBE == 7 && rp7_) GRID_BAR();
            if (PH & 128) { PHASE_ENV(); pg8::Gemm g{(const u16*)(ws + WS_BIG), (const u16*)(ws + WS_W_HOUT), NTOK, DM, DM}; pg8::StaticOrder S; S.init(NTOK, DM, G, blk);
              EpiRes<1> E{IN(I_XP), IN(I_XS), out, mods + 2 * 1024, (u16*)(ws + WS_H), IN(I_NFFN), mods + 4 * 1024, (float*)(ws + WS_ROWSS) + 1 * RSS_STRIDE, (LAS float*)(L + XCH_OFF)};
              pg8::gemm_phase<EpiRes<1>, pg8::StaticOrder, true, true>(L, g, S, E); }
            }
        } else {
            if (PH & 256) { PHASE_ENV(); u16* BIG = (u16*)(ws + WS_BIG); pg8::Gemm g{(const u16*)(ws + WS_H), (const u16*)(ws + WS_W_SIN), NTOK, 3072, DM}; pg8::StaticOrder S; S.init(NTOK, 3072, G, blk);
              EpiSconvIn E{BIG, BIG + PL, (const float*)(ws + WS_ROWSS) + 2 * RSS_STRIDE, (const float*)(ws + WS_BIAS) + 2 * BIAS_STRIDE, (LAS float*)(L + XCH_OFF)};
              pg8::gemm_phase<EpiSconvIn, pg8::StaticOrder, true, true>(L, g, S, E); }
            GRID_BAR();
            if (PH & 512) { PHASE_ENV(); u16* BIG = (u16*)(ws + WS_BIG); sconv_rows(BIG, BIG + PL, IN(I_SCW), IN(I_SCB), BIG + 2 * PL, blk * NWAVES * 64 + tid, G * NWAVES * 64); }
            GRID_BAR();
            if (PH & 1024) { PHASE_ENV(); pg8::Gemm g{(const u16*)(ws + WS_BIG) + 2 * PL, (const u16*)(ws + WS_W_SOUT), NTOK, DM, DM}; pg8::StaticOrder S; S.init(NTOK, DM, G, blk);
              EpiRes<1> E{out, out + (size_t)NCTX * DM, out, mods + 3 * NMODC + 2 * 1024, (u16*)(ws + WS_H), IN(I_NFFN) + DM, mods + 3 * NMODC + 4 * 1024, (float*)(ws + WS_ROWSS) + 3 * RSS_STRIDE, (LAS float*)(L + XCH_OFF)};
              pg8::gemm_phase<EpiRes<1>, pg8::StaticOrder, true, true>(L, g, S, E); }
        }
        GRID_BAR();
        for (int rp5_ = 0; rp5_ < ((PROBE == 5 && layer == 0) ? 2 : 1); ++rp5_) { if (rp5_) GRID_BAR();
        if (PH & 4096) { PHASE_ENV(); pg8::Gemm g{(const u16*)(ws + WS_H), (const u16*)(ws + (layer ? WS_W_UP1 : WS_W_UP0)), NTOK, 2 * DFF, DM}; pg8::StaticOrder S; S.init(NTOK, 2 * DFF, G, blk);
          EpiFfnUp E{(u16*)(ws + WS_BIG), IN(I_FCW) + (size_t)layer * 3 * DFF, IN(I_FCB) + (size_t)layer * DFF, (LAS float*)(L + XCH_OFF), (const float*)(ws + WS_ROWSS) + (layer ? 3 : 1) * RSS_STRIDE, (const float*)(ws + WS_BIAS) + (layer ? 3 : 1) * BIAS_STRIDE};
          pg8::gemm_phase<EpiFfnUp, pg8::StaticOrder, true, true>(L, g, S, E); }
        }
        GRID_BAR();
        if (PH & 8192) { PHASE_ENV(); pg8::Gemm g{(const u16*)(ws + WS_BIG), (const u16*)(ws + (layer ? WS_W_DN1 : WS_W_DN0)), NTOK, DM, DFF}; pg8::StaticOrder S; S.init(NTOK, DM, G, blk);
          if (layer == 0) { for (int rp9_ = (PROBE == 9 ? 0 : 1); rp9_ < 2; ++rp9_) { if (PROBE == 9 && rp9_) GRID_BAR();
          EpiRes<1> E{out, out + (size_t)NCTX * DM, out, rp9_ ? mods + 5 * 1024 : (const float*)(ws + 528 * 1024), (u16*)(ws + WS_H), IN(I_NMIX) + DM, mods + 3 * NMODC + 1 * 1024, (float*)(ws + WS_ROWSS) + 2 * RSS_STRIDE, (LAS float*)(L + XCH_OFF)};
            pg8::gemm_phase<EpiRes<1>, pg8::StaticOrder, true, true>(L, g, S, E); } }
          else { EpiRes<2> E{out, out + (size_t)NCTX * DM, out, mods + 3 * NMODC + 5 * 1024, nullptr, nullptr, nullptr, (float*)(ws + WS_ROWSS) + 4 * RSS_STRIDE, (LAS float*)(L + XCH_OFF)};
            pg8::gemm_phase<EpiRes<2>, pg8::StaticOrder, true, true>(L, g, S, E); } }
        GRID_BAR();
    }
    if (PH & 16384) { PHASE_ENV(); final_norm_rows(out, IN(I_FNW), (const float*)(ws + WS_ROWSS) + 4 * RSS_STRIDE, gw, NGW, lane); }
}

extern "C" void kernel_launch(void* const* d_in, const int* in_sizes, int n_in, void* d_out, int out_size, void* d_ws, size_t ws_size, hipStream_t stream) {
    static int grid = 0;
    if (grid == 0) {
        if (n_in != 22 || ws_size < WS_END) { fprintf(stderr, "kernel_launch: unexpected inputs (n_in %d, ws %zu)\n", n_in, ws_size); grid = -1; return; }
        int dev = 0, cus = 0, per_cu = 0;
        if (hipGetDevice(&dev) != hipSuccess || hipDeviceGetAttribute(&cus, hipDeviceAttributeMultiprocessorCount, dev) != hipSuccess) { grid = -1; return; }
        if (hipFuncSetAttribute((const void*)hgrn_dit_fwd, hipFuncAttributeMaxDynamicSharedMemorySize, LDS_BYTES) != hipSuccess) { fprintf(stderr, "kernel_launch: hipFuncSetAttribute failed\n"); grid = -1; return; }
        if (hipOccupancyMaxActiveBlocksPerMultiprocessor(&per_cu, (const void*)hgrn_dit_fwd, NWAVES * 64, LDS_BYTES) != hipSuccess || per_cu < 1) { fprintf(stderr, "kernel_launch: occupancy query says %d\n", per_cu); (void)hipGetLastError(); grid = -1; return; }
        grid = cus;
    }
    if (grid < 0) return;
    (void)hipMemsetAsync((char*)d_ws + WS_CTL, 0, CTL_ZERO_BYTES, stream);
    Args a{};
    for (int i = 0; i < 22; ++i) a.in[i] = (const float*)d_in[i];
    a.out = (float*)d_out; a.ws = (unsigned char*)d_ws;
    void* kargs[] = {&a};
    hipError_t e = hipLaunchCooperativeKernel((const void*)hgrn_dit_fwd, dim3(grid), dim3(NWAVES * 64), kargs, LDS_BYTES, stream);
    if (e != hipSuccess) fprintf(stderr, "kernel_launch: cooperative launch failed: %s (grid %d)\n", hipGetErrorString(e), grid);
}
```

```cpp
#include <hip/hip_runtime.h>
#include <cstdio>
#include <cstdint>
typedef float f32x2 __attribute__((ext_vector_type(2)));
namespace pg8 {
#define PG8_LAS __attribute__((address_space(3)))
typedef unsigned short bf16_t;
typedef short bf16x8 __attribute__((ext_vector_type(8)));
typedef float f32x4 __attribute__((ext_vector_type(4)));
typedef unsigned u32x4 __attribute__((ext_vector_type(4)));
constexpr int BM = 256, BK = 64, HALF = 128, HTB = HALF * BK * 2  , STAGE_BYTES = 8 * HTB, NXCD = 8, WGM = 8;

__host__ __device__ __forceinline__ int lds_byte(int r, int c) { const int st = (r >> 4) * 2 + (c >> 5), rr = r & 15, cc = c & 31, ob = rr * 64 + cc * 2; return st * 1024 + (ob ^ (((ob >> 9) & 1) << 5)); }
__host__ __device__ __forceinline__ void stage_rc(int b, int& R, int& C) { const int st = b / 1024, sb = b % 1024, swz = sb ^ (((sb >> 9) & 1) << 5); R = (st >> 1) * 16 + swz / 64; C = (st & 1) * 32 + (swz % 64) / 2; }
__host__ __device__ __forceinline__ int perm32(int rho) { const int n = rho >> 4, i = rho & 15; return 8 * (i >> 2) + 4 * n + (i & 3); }

struct Unit { int pm, pn; };
struct Gemm { const bf16_t* A; const bf16_t* Bt; int M, N, K; };

struct StaticOrder {
    int nM, nN, nwg, G, c;
    __host__ __device__ void init(int M, int N, int G_, int c_) { nM = M / BM; nN = N / BM; nwg = nM * nN; G = G_; c = c_; }
    __host__ __device__ bool next(int i, Unit& u) const {
        const long L = (long)i * G + c; if (L >= nwg) return false;
        int wgid = (int)L; { const int q = nwg / NXCD, r = nwg % NXCD, xcd = wgid % NXCD, off = wgid / NXCD; wgid = (xcd < r ? xcd * (q + 1) : r * (q + 1) + (xcd - r) * q) + off; }
        const int nig = WGM * nN, gid = wgid / nig, fm = gid * WGM, gsz = (nM - fm) < WGM ? (nM - fm) : WGM;
        u.pm = fm + ((wgid % nig) % gsz); u.pn = (wgid % nig) / gsz; return true;
    }
    __device__ __forceinline__ void a_ready(const Unit&) const {}
    __device__ __forceinline__ void done(const Unit&) const {}
};

template <class Epi, class Sched, bool ALIGN_EPI = false, bool SP2 = false>
__device__ __forceinline__ void gemm_phase(PG8_LAS unsigned char* lds, const Gemm g, const Sched& S, const Epi& E) {
    int tid_ = threadIdx.x; asm volatile("" : "+v"(tid_));
    const int tid = tid_, wid = __builtin_amdgcn_readfirstlane(tid >> 6), lane = tid & 63, wr = wid >> 2, wc = wid & 3, fr = lane & 15, fq = lane >> 4;
    const int K = g.K, nt = K / BK;
    unsigned voffA[2], voffB[2];
#pragma unroll
    for (int i = 0; i < 2; ++i) { int R, C; stage_rc(tid * 16 + i * 8192, R, C); const int Rb = Epi::PERM ? ((R & ~31) + perm32(R & 31)) : R;
        voffA[i] = (unsigned)(R * K + C) * 2u; voffB[i] = (unsigned)(Rb * K + C) * 2u; }
    const size_t kstep = (size_t)(BK * 2);
    const size_t hstep = (size_t)HALF * K * 2;
    const size_t tstep = 2 * hstep;
    const unsigned ldsw = (unsigned)wid * 1024u;
    const int aoff = lds_byte(wr * 64 + fr, fq * 8), boff = lds_byte(wc * 32 + fr, fq * 8);
#define PG8_SA(b, h) (((b) * 2 + (h)) * HTB)
#define PG8_SB(b, h) ((4 + (b) * 2 + (h)) * HTB)
#define PG8_STAGE(bufoff, gbase, voff) do { _Pragma("unroll") for (int _i = 0; _i < 2; ++_i) \
        __builtin_amdgcn_global_load_lds((const unsigned*)((const char*)(gbase) + (voff)[_i]), (PG8_LAS unsigned*)(lds + (bufoff) + ldsw + _i * 8192), 16, 0, 0); } while (0)
#define PG8_LDA(dst, b, h) do { _Pragma("unroll") for (int m = 0; m < 4; ++m) _Pragma("unroll") for (int k = 0; k < 2; ++k) dst[m][k] = *(const PG8_LAS bf16x8*)(lds + PG8_SA(b, h) + aoff + m * 2048 + k * 1024); } while (0)
#define PG8_LDB(dst, b, h) do { _Pragma("unroll") for (int n = 0; n < 2; ++n) _Pragma("unroll") for (int k = 0; k < 2; ++k) dst[n][k] = *(const PG8_LAS bf16x8*)(lds + PG8_SB(b, h) + boff + n * 2048 + k * 1024); } while (0)
#define PG8_MMA(ai, bj, At, Bt) do { __builtin_amdgcn_s_setprio(1); _Pragma("unroll") for (int m = 0; m < 4; ++m) _Pragma("unroll") for (int n = 0; n < 2; ++n) _Pragma("unroll") for (int k = 0; k < 2; ++k) \
        acc[ai][bj][m][n] = __builtin_amdgcn_mfma_f32_16x16x32_bf16(Bt[n][k], At[m][k], acc[ai][bj][m][n], 0, 0, 0); __builtin_amdgcn_s_setprio(0); } while (0)
#define PG8_WAIT_V(n) asm volatile("s_waitcnt vmcnt(" #n ")" ::: "memory")
#define PG8_WAIT_L(n) asm volatile("s_waitcnt lgkmcnt(" #n ")" ::: "memory")
#define PG8_BAR __builtin_amdgcn_s_barrier()
#define PG8_SCHED __builtin_amdgcn_sched_barrier(0)
    Unit cur, nxt; int ui = 0;
    if (!S.next(0, cur)) return;
    f32x4 acc[2][2][4][2];
#pragma unroll
    for (int a = 0; a < 2; ++a)
#pragma unroll
        for (int b = 0; b < 2; ++b)
#pragma unroll
            for (int m = 0; m < 4; ++m)
#pragma unroll
                for (int n = 0; n < 2; ++n) acc[a][b][m][n] = (f32x4){0.f, 0.f, 0.f, 0.f};
    bf16x8 At[4][2], B0[2][2], B1[2][2];
    const char* cA = (const char*)g.A + (size_t)cur.pm * tstep; const char* cB = (const char*)g.Bt + (size_t)cur.pn * tstep;
    S.a_ready(cur);
    if constexpr (SP2) {
        PG8_STAGE(PG8_SB(0, 0), cB, voffB); PG8_STAGE(PG8_SB(0, 1), cB + hstep, voffB); PG8_STAGE(PG8_SA(0, 0), cA, voffA); PG8_STAGE(PG8_SA(0, 1), cA + hstep, voffA);
        if (wr == 1) PG8_BAR;
        PG8_WAIT_V(2); PG8_BAR;
        PG8_STAGE(PG8_SB(1, 0), cB + kstep, voffB); PG8_STAGE(PG8_SA(1, 0), cA + kstep, voffA); PG8_STAGE(PG8_SB(1, 1), cB + hstep + kstep, voffB);
        PG8_WAIT_V(6); PG8_BAR;
    } else {
        PG8_STAGE(PG8_SB(0, 0), cB, voffB); PG8_STAGE(PG8_SA(0, 0), cA, voffA); PG8_STAGE(PG8_SB(0, 1), cB + hstep, voffB); PG8_STAGE(PG8_SA(0, 1), cA + hstep, voffA);
        if (wr == 1) PG8_BAR;
        PG8_WAIT_V(4); PG8_BAR;
        PG8_STAGE(PG8_SB(1, 0), cB + kstep, voffB); PG8_STAGE(PG8_SA(1, 0), cA + kstep, voffA); PG8_STAGE(PG8_SB(1, 1), cB + hstep + kstep, voffB);
        PG8_WAIT_V(6); PG8_BAR;
    }
    for (;;) {
        const bool has_next = S.next(ui + 1, nxt);
        const char* nA = has_next ? (const char*)g.A + (size_t)nxt.pm * tstep : cA; const char* nB = has_next ? (const char*)g.Bt + (size_t)nxt.pn * tstep : cB;
        for (int t = 0; t < nt; t += 2) {
            const bool last = (t == nt - 2);
            const char* a1 = cA + (size_t)(t + 1) * kstep;
            const char* a2 = last ? nA : cA + (size_t)(t + 2) * kstep; const char* b2 = last ? nB : cB + (size_t)(t + 2) * kstep;
            const char* a3 = a2 + kstep; const char* b3 = b2 + kstep;
            if (last && has_next) S.a_ready(nxt);
            if constexpr (SP2) {
            PG8_LDB(B0, 0, 0); PG8_LDB(B1, 0, 1); PG8_SCHED; PG8_LDA(At, 0, 0); PG8_STAGE(PG8_SA(1, 1), a1 + hstep, voffA);
            PG8_WAIT_V(8); PG8_WAIT_L(0); PG8_BAR; PG8_MMA(0, 0, At, B0); PG8_MMA(0, 1, At, B1); PG8_BAR; PG8_SCHED;
            PG8_LDA(At, 0, 1); PG8_STAGE(PG8_SB(0, 0), b2, voffB); PG8_STAGE(PG8_SB(0, 1), b2 + hstep, voffB); PG8_STAGE(PG8_SA(0, 0), a2, voffA);
            PG8_WAIT_V(8); PG8_WAIT_L(0); PG8_BAR; PG8_MMA(1, 0, At, B0); PG8_MMA(1, 1, At, B1); PG8_BAR; PG8_SCHED;
            PG8_LDB(B0, 1, 0); PG8_LDB(B1, 1, 1); PG8_SCHED; PG8_LDA(At, 1, 0); PG8_STAGE(PG8_SA(0, 1), a2 + hstep, voffA);
            PG8_WAIT_V(8); PG8_WAIT_L(0); PG8_BAR; PG8_MMA(0, 0, At, B0); PG8_MMA(0, 1, At, B1); PG8_BAR; PG8_SCHED;
            PG8_LDA(At, 1, 1); PG8_STAGE(PG8_SB(1, 0), b3, voffB); PG8_STAGE(PG8_SB(1, 1), b3 + hstep, voffB); PG8_STAGE(PG8_SA(1, 0), a3, voffA);
            PG8_WAIT_V(8); PG8_WAIT_L(0); PG8_BAR; PG8_MMA(1, 0, At, B0); PG8_MMA(1, 1, At, B1); PG8_BAR; PG8_SCHED;
            } else {
            PG8_LDB(B0, 0, 0); PG8_SCHED; PG8_LDA(At, 0, 0); PG8_STAGE(PG8_SA(1, 1), a1 + hstep, voffA);
            PG8_WAIT_L(8); PG8_BAR; PG8_WAIT_L(0); PG8_MMA(0, 0, At, B0); PG8_BAR; PG8_SCHED;
            PG8_LDB(B1, 0, 1); PG8_STAGE(PG8_SB(0, 0), b2, voffB);
            PG8_BAR; PG8_WAIT_L(0); PG8_MMA(0, 1, At, B1); PG8_BAR;
            PG8_LDA(At, 0, 1); PG8_STAGE(PG8_SA(0, 0), a2, voffA);
            PG8_BAR; PG8_WAIT_L(0); PG8_MMA(1, 0, At, B0); PG8_BAR; PG8_SCHED;
            PG8_STAGE(PG8_SB(0, 1), b2 + hstep, voffB);
            PG8_WAIT_V(6); PG8_BAR; PG8_MMA(1, 1, At, B1); PG8_BAR;
            PG8_LDB(B0, 1, 0); PG8_SCHED; PG8_LDA(At, 1, 0); PG8_STAGE(PG8_SA(0, 1), a2 + hstep, voffA);
            PG8_WAIT_L(8); PG8_BAR; PG8_WAIT_L(0); PG8_MMA(0, 0, At, B0); PG8_BAR; PG8_SCHED;
            PG8_LDB(B1, 1, 1); PG8_STAGE(PG8_SB(1, 0), b3, voffB);
            PG8_BAR; PG8_WAIT_L(0); PG8_MMA(0, 1, At, B1); PG8_BAR;
            PG8_LDA(At, 1, 1); PG8_STAGE(PG8_SA(1, 0), a3, voffA);
            PG8_BAR; PG8_WAIT_L(0); PG8_MMA(1, 0, At, B0); PG8_BAR; PG8_SCHED;
            PG8_STAGE(PG8_SB(1, 1), b3 + hstep, voffB);
            PG8_WAIT_V(6); PG8_BAR; PG8_MMA(1, 1, At, B1); PG8_BAR;
            }
        }
        if constexpr (ALIGN_EPI) { if (wr == 0) PG8_BAR; }
        if constexpr (!Epi::AFTER_DRAIN) { E(acc, cur, wr, wc, fr, fq); S.done(cur); }
        if (!has_next) break;
#pragma unroll
        for (int a = 0; a < 2; ++a)
#pragma unroll
            for (int b = 0; b < 2; ++b)
#pragma unroll
                for (int m = 0; m < 4; ++m)
#pragma unroll
                    for (int n = 0; n < 2; ++n) acc[a][b][m][n] = (f32x4){0.f, 0.f, 0.f, 0.f};
        cur = nxt; cA = nA; cB = nB; ++ui;
        if constexpr (ALIGN_EPI) { if (wr == 1) PG8_BAR; }
    }
    PG8_WAIT_V(0);
    if constexpr (!ALIGN_EPI) { if (wr == 0) PG8_BAR; }
    PG8_BAR;
    if constexpr (Epi::AFTER_DRAIN) { E.fused(acc, cur, wr, wc, fr, fq, lds, wid, lane); S.done(cur); }
#undef PG8_SA
#undef PG8_SB
#undef PG8_STAGE
#undef PG8_LDA
#undef PG8_LDB
#undef PG8_MMA
#undef PG8_WAIT_V
#undef PG8_WAIT_L
#undef PG8_BAR
#undef PG8_SCHED
}
}

constexpr int NWAVES = 8;
constexpr int DM = 1024, NTOK = 16384, NCTX = 8192, DFF = 2816, NMODC = 6144;
constexpr float EPSN = 1e-6f;
constexpr size_t MiB = 1u << 20;
constexpr size_t PL = (size_t)NTOK * DM;
constexpr size_t WS_CTL = 0, CTL_ZERO_BYTES = 1 * MiB;
constexpr int    CW_BAR = 4096;
constexpr size_t WS_MODS = 64 * 1024;
constexpr size_t WS_LB = 208 * 1024;
constexpr size_t WS_BIAS = 256 * 1024;
constexpr size_t WS_ROWSS = 247 * MiB;
constexpr int BIAS_STRIDE = 3 * 5632, RSS_STRIDE = 4 * NTOK;
constexpr size_t WS_W_HIN = 1 * MiB, WS_W_HOUT = 11 * MiB, WS_W_SIN = 13 * MiB, WS_W_SOUT = 19 * MiB;
constexpr size_t WS_W_UP0 = 21 * MiB, WS_W_UP1 = 32 * MiB, WS_W_DN0 = 43 * MiB, WS_W_DN1 = 43 * MiB + 5767168;
constexpr size_t WS_H = 54 * MiB;
constexpr size_t WS_BIG = 86 * MiB;
constexpr size_t WS_SEGD = 246 * MiB;
constexpr size_t WS_END = 256 * MiB;
static_assert(WS_W_DN1 + 5767168 == WS_H && WS_BIG + 5 * PL * 2 == WS_SEGD, "ws map");
constexpr int RING_BYTES = 131072, XCH_OFF = RING_BYTES, XCH_BYTES = 8192, MISC_OFF = XCH_OFF + XCH_BYTES, LDS_BYTES = 147456;

#define GAS __attribute__((address_space(1)))
#define LAS __attribute__((address_space(3)))
typedef unsigned short u16;
typedef unsigned u32x4 __attribute__((ext_vector_type(4)));
typedef unsigned u32x2 __attribute__((ext_vector_type(2)));
typedef float f32x4 __attribute__((ext_vector_type(4)));
typedef short bf16x8 __attribute__((ext_vector_type(8)));
typedef __bf16 bf16x2_t __attribute__((ext_vector_type(2)));
typedef _Float16 f16x2_t __attribute__((ext_vector_type(2)));
#define LBAR() do { asm volatile("s_waitcnt lgkmcnt(0)" ::: "memory"); __builtin_amdgcn_s_barrier(); asm volatile("" ::: "memory"); } while (0)

__device__ __forceinline__ unsigned pk2(float lo, float hi) { f32x2 v = {lo, hi}; bf16x2_t b = __builtin_convertvector(v, bf16x2_t); return __builtin_bit_cast(unsigned, b); }
__device__ __forceinline__ unsigned pkh2(float lo, float hi) { f32x2 v = {lo, hi}; f16x2_t b = __builtin_convertvector(v, f16x2_t); return __builtin_bit_cast(unsigned, b); }
__device__ __forceinline__ float bflo(unsigned u) { return __builtin_bit_cast(float, u << 16); }
__device__ __forceinline__ float bfhi(unsigned u) { return __builtin_bit_cast(float, u & 0xffff0000u); }
__device__ __forceinline__ float bf1(u16 u) { return __builtin_bit_cast(float, (unsigned)u << 16); }
__device__ __forceinline__ float hlo(unsigned u) { return (float)__builtin_bit_cast(_Float16, (u16)(u & 0xffffu)); }
__device__ __forceinline__ float hhi(unsigned u) { return (float)__builtin_bit_cast(_Float16, (u16)(u >> 16)); }
__device__ __forceinline__ float frcp(float x) { return __builtin_amdgcn_rcpf(x); }
__device__ __forceinline__ float frsq(float x) { return __builtin_amdgcn_rsqf(x); }
__device__ __forceinline__ float siluf(float x) { return x * frcp(1.f + __expf(-x)); }
template <int CTRL> __device__ __forceinline__ float dppf(float v) { return __builtin_bit_cast(float, __builtin_amdgcn_update_dpp(0, __builtin_bit_cast(int, v), CTRL, 0xF, 0xF, true)); }
__device__ __forceinline__ float row16_sum(float v) { v += dppf<0xB1>(v); v += dppf<0x4E>(v); v += dppf<0x141>(v); v += dppf<0x140>(v); return v; }
__device__ __forceinline__ float wave_sum(float v) {
#pragma unroll
    for (int o = 1; o < 64; o <<= 1) v += __shfl_xor(v, o);
    return v;
}
__device__ __forceinline__ int row_group(int row) { return row < NCTX ? 0 : 1 + ((row - NCTX) >> 12); }

#define XB_TMO      128
#define XB_XCNT(j)  (256  + 64 * (j))
#define XB_XSUB(j)  (1280 + 64 * (j))
#define XB_XGEN(j)  (2304 + 64 * (j))
#define XB_TOP      3328
#define XB_TOPGEN   3392
#define XCD_BAR_WORDS 3456
#define XB_SPIN_CAP (1u << 18)

__device__ __forceinline__ unsigned xb_ld(unsigned* p)              { return __hip_atomic_load(p, __ATOMIC_RELAXED, __HIP_MEMORY_SCOPE_AGENT); }
__device__ __forceinline__ unsigned xb_add(unsigned* p, unsigned v) { return __hip_atomic_fetch_add(p, v, __ATOMIC_RELAXED, __HIP_MEMORY_SCOPE_AGENT); }
__device__ __forceinline__ unsigned xb_xcc_id() { return (unsigned)__builtin_amdgcn_s_getreg((3 << 11) | 20) & 0xFu; }
#define XB_SPIN(cond, bar) do { unsigned _sp = 0; while (cond) { __builtin_amdgcn_s_sleep(1); \
    if ((++_sp & 255u) == 0u) { if (xb_ld(&(bar)[XB_TMO])) break; if (_sp > XB_SPIN_CAP) { atomicAdd(&(bar)[XB_TMO], 1u); break; } } } } while (0)

struct XcdBarrier {
    unsigned* bar; unsigned x;
    volatile LAS unsigned* st;
};

__device__ __forceinline__ XcdBarrier xcd_barrier_post(unsigned* bar, volatile LAS unsigned* st) {
    XcdBarrier b; b.bar = bar; b.x = xb_xcc_id(); b.st = st;
    if (threadIdx.x == 0) (void)xb_add(&bar[XB_XCNT(b.x)], 1u);
    return b;
}
__device__ __forceinline__ void xcd_barrier_complete(unsigned* bar, unsigned x, unsigned& nloc, unsigned& nx) {
    const unsigned G = gridDim.x * gridDim.y * gridDim.z;
    unsigned sum, cnt, mine, sp = 0u;
    for (;;) {
        sum = 0u; cnt = 0u; mine = 0u;
#pragma unroll
        for (unsigned j = 0; j < 16; ++j) { const unsigned c = xb_ld(&bar[XB_XCNT(j)]); sum += c; cnt += (c > 0u) ? 1u : 0u; mine = (j == x) ? c : mine; }
        if (sum == G) break;
        __builtin_amdgcn_s_sleep(1);
        if ((++sp & 255u) == 0u) { if (xb_ld(&bar[XB_TMO])) break; if (sp > XB_SPIN_CAP) { atomicAdd(&bar[XB_TMO], 1u); break; } }
    }
    nloc = mine > 0u ? mine : 1u; nx = cnt > 0u ? cnt : 1u;
}

__device__ __forceinline__ void xcd_barrier(const XcdBarrier& b) {
    asm volatile("s_waitcnt vmcnt(0)" ::: "memory");
    __syncthreads();
    if (threadIdx.x == 0) {
        unsigned* bar = b.bar;
        __builtin_amdgcn_s_waitcnt(0);
        unsigned nloc = b.st[0], nx = b.st[1];
        if (nloc == 0u) { xcd_barrier_complete(bar, b.x, nloc, nx); b.st[0] = nloc; b.st[1] = nx; }
        const unsigned old = xb_add(&bar[XB_XSUB(b.x)], 1u);
        const unsigned gen = old / nloc;
        if (old + 1u == (gen + 1u) * nloc) {
            __builtin_amdgcn_fence(__ATOMIC_RELEASE, "agent");
            asm volatile("s_waitcnt vmcnt(0)" ::: "memory");
            const unsigned og = xb_add(&bar[XB_TOP], 1u);
            const unsigned tg = og / nx;
            if (og + 1u == (tg + 1u) * nx) xb_add(&bar[XB_TOPGEN], 1u);
            else XB_SPIN(xb_ld(&bar[XB_TOPGEN]) == tg, bar);
            __builtin_amdgcn_fence(__ATOMIC_ACQUIRE, "agent");
            xb_add(&bar[XB_XGEN(b.x)], 1u);
            asm volatile("s_waitcnt vmcnt(0)" ::: "memory");
        } else {
            XB_SPIN(xb_ld(&bar[XB_XGEN(b.x)]) == gen, bar);
            __builtin_amdgcn_fence(__ATOMIC_ACQUIRE, "agent");
            asm volatile("s_waitcnt vmcnt(0)" ::: "memory");
        }
    }
    __syncthreads();
}

using pg8::Unit;
__device__ __forceinline__ float rstd4(const float* p) { return frsq(((p[0] + p[NTOK]) + (p[2 * NTOK] + p[3 * NTOK])) * (1.f / DM) + EPSN); }

struct EpiProj {
    static constexpr bool PERM = true, AFTER_DRAIN = false;
    u16* planes; const float* lb; const float* rowss; const float* bias; LAS float* xch;
    __device__ __forceinline__ void operator()(const f32x4 (&acc)[2][2][4][2], const Unit& u, int wr_, int wc_, int fr_, int fq_) const {
        int fr = fr_, fq = fq_, wr = wr_, wc = wc_; asm volatile("" : "+v"(fr), "+v"(fq), "+s"(wr), "+s"(wc));
        const int plane = u.pn >> 2, colt = (u.pn & 3) * 256;
        const bool isgate = (plane == 1 || plane == 2), issilu = (plane == 0 || plane == 4);
        {
            int t = threadIdx.x; asm volatile("" : "+v"(t));
            if (t < 256) xch[1792 + t] = rstd4(rowss + u.pm * 256 + t);
            else if (t < 320) { const int c4 = (t - 256) * 4; *(LAS f32x4*)(xch + 1024 + c4) = *(const f32x4*)(bias + row_group(u.pm * 256) * 5632 + u.pn * 256 + c4); }
            else if (t < 384) { const int c4 = (t - 320) * 4; *(LAS f32x4*)(xch + 1280 + c4) = *(const f32x4*)(lb + (isgate ? (plane - 1) * 1024 : 0) + colt + c4); }
        }
        LBAR();
        u16* base = planes + (size_t)plane * PL;
        const int row0 = u.pm * 256 + wr * 64 + fr, col0 = colt + wc * 32 + 8 * fq;
        const LAS float* bl = xch + 1024 + wc * 32 + 8 * fq;
        const LAS float* ll = xch + 1280 + wc * 32 + 8 * fq;
        const LAS float* rl = xch + 1792 + wr * 64 + fr;
#pragma unroll
        for (int ai = 0; ai < 2; ++ai)
#pragma unroll
            for (int m = 0; m < 4; ++m) {
                u16* rowp = base + (size_t)(row0 + ai * 128 + m * 16) * DM + col0;
                const float rs = rl[ai * 128 + m * 16];
#pragma unroll
                for (int bj = 0; bj < 2; ++bj) {
                    float x[8];
#pragma unroll
                    for (int n = 0; n < 2; ++n) { const f32x4 bv = *(const LAS f32x4*)(bl + bj * 128 + 4 * n);
#pragma unroll
                        for (int i = 0; i < 4; ++i) x[4 * n + i] = acc[ai][bj][m][n][i] * rs + bv[i]; }
                    u32x4 w;
                    if (isgate) {
                        const f32x4 l0 = *(const LAS f32x4*)(ll + bj * 128), l1 = *(const LAS f32x4*)(ll + bj * 128 + 4);
#pragma unroll
                        for (int e = 0; e < 8; ++e) { const float l = e < 4 ? l0[e & 3] : l1[e & 3]; const float sg = frcp(1.f + __expf(-x[e])); x[e] = __logf(l + (1.f - l) * sg); }
                        w.x = pkh2(x[0], x[1]); w.y = pkh2(x[2], x[3]); w.z = pkh2(x[4], x[5]); w.w = pkh2(x[6], x[7]);
                    } else {
                        if (issilu) {
#pragma unroll
                            for (int e = 0; e < 8; ++e) x[e] = siluf(x[e]);
                        }
                        w.x = pk2(x[0], x[1]); w.y = pk2(x[2], x[3]); w.z = pk2(x[4], x[5]); w.w = pk2(x[6], x[7]);
                    }
                    *(u32x4*)(rowp + bj * 128) = w;
                }
            }
    }
};

template <int NEXT, bool RES16> struct EpiRes {
    static constexpr bool PERM = false, AFTER_DRAIN = false;
    const float* resA; const float* resB; u16* x16; const float* gate;
    u16* An; const float* nw; const float* scale; float* rowss; LAS float* xch;
    __device__ __forceinline__ void operator()(const f32x4 (&acc)[2][2][4][2], const Unit& u, int wr_, int wc_, int fr_, int fq_) const {
        int fr = fr_, fq = fq_, wr = wr_, wc = wc_; asm volatile("" : "+v"(fr), "+v"(fq), "+s"(wr), "+s"(wc));
        const int row0 = u.pm * 256 + wr * 64 + fr, col0 = u.pn * 256 + wc * 32 + 4 * fq;
        const int grp = row_group(u.pm * 256);
        const float* gp = gate + grp * NMODC + col0;
        f32x4 gv[2][2], wm[2][2];
#pragma unroll
        for (int bj = 0; bj < 2; ++bj)
#pragma unroll
            for (int n = 0; n < 2; ++n) { gv[bj][n] = *(const f32x4*)(gp + bj * 128 + n * 16);
                if (NEXT == 1) wm[bj][n] = *(const f32x4*)(nw + col0 + bj * 128 + n * 16) * (*(const f32x4*)(scale + grp * NMODC + col0 + bj * 128 + n * 16) + 1.0f); }
#pragma unroll
        for (int ai = 0; ai < 2; ++ai)
#pragma unroll
            for (int m = 0; m < 4; ++m) {
                const int row = row0 + ai * 128 + m * 16;
                const float* rp = (row < NCTX ? resA + (size_t)row * DM : resB + (size_t)(row - NCTX) * DM) + col0;
                u16* op = x16 + (size_t)row * DM + col0;
                float ss = 0.f;
#pragma unroll
                for (int bj = 0; bj < 2; ++bj)
#pragma unroll
                    for (int n = 0; n < 2; ++n) { f32x4 r;
                        if (RES16) { const u32x2 h = *(const u32x2*)(op + bj * 128 + n * 16); r = (f32x4){hlo(h.x), hhi(h.x), hlo(h.y), hhi(h.y)}; } else r = *(const f32x4*)(rp + bj * 128 + n * 16);
                        const f32x4 o = r + gv[bj][n] * acc[ai][bj][m][n]; { u32x2 h; h.x = pkh2(o[0], o[1]); h.y = pkh2(o[2], o[3]); *(u32x2*)(op + bj * 128 + n * 16) = h; }
                        if (NEXT >= 1) ss += (o[0] * o[0] + o[1] * o[1]) + (o[2] * o[2] + o[3] * o[3]);
                        if (NEXT == 1) { const f32x4 a = o * wm[bj][n]; u32x2 p; p.x = pk2(a[0], a[1]); p.y = pk2(a[2], a[3]); *(u32x2*)(An + (size_t)row * DM + col0 + bj * 128 + n * 16) = p; } }
                if (NEXT >= 1) { ss += __shfl_xor(ss, 16); ss += __shfl_xor(ss, 32); if (fq == 0) xch[wc * 256 + ai * 128 + wr * 64 + m * 16 + fr] = ss; }
            }
        if (NEXT >= 1) {
            LBAR();
            int t = threadIdx.x; asm volatile("" : "+v"(t));
            if (t < 256) rowss[(size_t)u.pn * NTOK + u.pm * 256 + t] = (xch[t] + xch[256 + t]) + (xch[512 + t] + xch[768 + t]);
        }
    }
};

struct EpiFfnUp {
    static constexpr bool PERM = true, AFTER_DRAIN = false;
    u16* act; const float* cw; const float* cb; LAS float* xch; const float* rowss; const float* bias;
    __device__ __forceinline__ void operator()(const f32x4 (&acc)[2][2][4][2], const Unit& u, int wr_, int wc_, int fr_, int fq_) const {
        int fr = fr_, fq = fq_, wr = wr_, wc = wc_; asm volatile("" : "+v"(fr), "+v"(fq), "+s"(wr), "+s"(wc));
        const int lane = (fq << 4) | fr;
        const bool ctx = (u.pm * 256) < NCTX;
        const int colq = wc * 32 + 8 * fq;
        const int gcol = u.pn * 128 + colq;
        {
            int t = threadIdx.x; asm volatile("" : "+v"(t));
            if (t < 256) xch[1792 + t] = rstd4(rowss + u.pm * 256 + t);
            else if (t < 448) { const int q = t - 256, v = q >> 5, c4 = (q & 31) * 4; const float* bt = bias + row_group(u.pm * 256) * 5632 + u.pn * 256;
                const f32x4 x = v < 3 ? *(const f32x4*)(cw + v * DFF + u.pn * 128 + c4) : v == 3 ? *(const f32x4*)(cb + u.pn * 128 + c4) : *(const f32x4*)(bt + (v - 4) * 128 + c4);
                *(LAS f32x4*)(xch + 1024 + v * 128 + c4) = x; }
        }
        if (fr == 0 || fr == 15) {
#pragma unroll
            for (int ai = 0; ai < 2; ++ai) {
                LAS float* p = xch + (((wr * 4 + wc) * 2 + ai) * 2 + (fr == 0 ? 0 : 1)) * 32 + 8 * fq;
                *(LAS f32x4*)p = fr == 0 ? acc[ai][0][0][0] : acc[ai][0][3][0]; *(LAS f32x4*)(p + 4) = fr == 0 ? acc[ai][0][0][1] : acc[ai][0][3][1];
            }
        }
        LBAR();
        const LAS float* cwl = xch + 1024 + colq;
        const LAS float* rl = xch + 1792;
#pragma unroll
        for (int ai = 0; ai < 2; ++ai) {
            const bool has_u = ctx && (wr == 1 || ai == 1);
            const int uai = wr == 1 ? ai : 0;
            const bool has_d = ctx && (wr == 0 || ai == 0);
            const int dai = wr == 0 ? ai : 1;
            const LAS float* pu = xch + ((((1 - wr) * 4 + wc) * 2 + uai) * 2 + 1) * 32 + 8 * fq;
            const LAS float* pd = xch + ((((1 - wr) * 4 + wc) * 2 + dai) * 2 + 0) * 32 + 8 * fq;
            const int rbase = ai * 128 + wr * 64;
            const float rsu = has_u ? rl[rbase - 1] : 0.f, rsd = has_d ? rl[rbase + 64] : 0.f;
            float rs[4];
#pragma unroll
            for (int m = 0; m < 4; ++m) rs[m] = rl[rbase + m * 16 + fr];
#define FU_A(m, n, i) (acc[ai][0][m][n][i] * rs[m] + ba[i])
#pragma unroll
            for (int m = 0; m < 4; ++m) {
                unsigned wv[4];
#pragma unroll
                for (int n = 0; n < 2; ++n) {
                    const f32x4 ba = *(const LAS f32x4*)(cwl + 4 * 128 + 4 * n), bgq = *(const LAS f32x4*)(cwl + 5 * 128 + 4 * n);
                    const f32x4 w0q = *(const LAS f32x4*)(cwl + 4 * n), w1q = *(const LAS f32x4*)(cwl + 128 + 4 * n), w2q = *(const LAS f32x4*)(cwl + 256 + 4 * n), bbq = *(const LAS f32x4*)(cwl + 384 + 4 * n);
                    float o[4];
#pragma unroll
                    for (int i = 0; i < 4; ++i) {
                        const float a = FU_A(m, n, i);
                        const float tu = (m > 0 && fr == 15) ? FU_A((m > 0 ? m - 1 : 0), n, i) : a;
                        const float td = (m < 3 && fr == 0) ? FU_A((m < 3 ? m + 1 : 3), n, i) : a;
                        float up = dppf<0x121>(tu), dn = dppf<0x12F>(td);
                        if (m == 0) { const float x = has_u ? pu[4 * n + i] * rsu + ba[i] : 0.f; if (fr == 0) up = x; }
                        if (m == 3) { const float x = has_d ? pd[4 * n + i] * rsd + ba[i] : 0.f; if (fr == 15) dn = x; }
                        const float cv = w0q[i] * up + w1q[i] * a + w2q[i] * dn + bbq[i];
                        o[i] = siluf(cv) * (acc[ai][1][m][n][i] * rs[m] + bgq[i]);
                    }
                    wv[2 * n] = pk2(o[0], o[1]); wv[2 * n + 1] = pk2(o[2], o[3]);
                }
                u32x4 w; w.x = wv[0]; w.y = wv[1]; w.z = wv[2]; w.w = wv[3];
                *(u32x4*)(act + (size_t)(u.pm * 256 + ai * 128 + wr * 64 + m * 16 + fr) * DFF + gcol) = w;
            }
#undef FU_A
        }
    }
};

struct EpiSconvIn {
    static constexpr bool PERM = true, AFTER_DRAIN = false;
    u16* cu; u16* gb; const float* rowss; const float* bias; LAS float* xch;
    __device__ __forceinline__ void operator()(const f32x4 (&acc)[2][2][4][2], const Unit& u, int wr_, int wc_, int fr_, int fq_) const {
        int fr = fr_, fq = fq_, wr = wr_, wc = wc_; asm volatile("" : "+v"(fr), "+v"(fq), "+s"(wr), "+s"(wc));
        {
            int t = threadIdx.x; asm volatile("" : "+v"(t));
            if (t < 256) xch[1792 + t] = rstd4(rowss + u.pm * 256 + t);
            else if (t < 320) { const int c4 = (t - 256) * 4; *(LAS f32x4*)(xch + 1024 + c4) = *(const f32x4*)(bias + row_group(u.pm * 256) * 5632 + u.pn * 256 + c4); }
        }
        LBAR();
        const int row0 = u.pm * 256 + wr * 64 + fr, colq = wc * 32 + 8 * fq;
        const LAS float* bl = xch + 1024 + colq;
        const LAS float* rl = xch + 1792 + wr * 64 + fr;
        const f32x4 b00 = *(const LAS f32x4*)(bl), b01 = *(const LAS f32x4*)(bl + 4), b10 = *(const LAS f32x4*)(bl + 128), b11 = *(const LAS f32x4*)(bl + 132);
#pragma unroll
        for (int ai = 0; ai < 2; ++ai)
#pragma unroll
            for (int m = 0; m < 4; ++m) {
                const size_t ro = (size_t)(row0 + ai * 128 + m * 16) * DM;
                const float rs = rl[ai * 128 + m * 16];
                if (u.pn < 8) {
                    const f32x4 p0 = (acc[ai][0][m][0] * rs + b00) * (acc[ai][1][m][0] * rs + b10), p1 = (acc[ai][0][m][1] * rs + b01) * (acc[ai][1][m][1] * rs + b11);
                    u32x4 w; w.x = pk2(p0[0], p0[1]); w.y = pk2(p0[2], p0[3]); w.z = pk2(p1[0], p1[1]); w.w = pk2(p1[2], p1[3]);
                    *(u32x4*)(cu + ro + u.pn * 128 + colq) = w;
                } else {
#pragma unroll
                    for (int bj = 0; bj < 2; ++bj) { const f32x4 p0 = acc[ai][bj][m][0] * rs + (bj ? b10 : b00), p1 = acc[ai][bj][m][1] * rs + (bj ? b11 : b01);
                        u32x4 w; w.x = pk2(p0[0], p0[1]); w.y = pk2(p0[2], p0[3]); w.z = pk2(p1[0], p1[1]); w.w = pk2(p1[2], p1[3]);
                        *(u32x4*)(gb + ro + (u.pn - 8) * 256 + bj * 128 + colq) = w; }
                }
            }
    }
};

__device__ __forceinline__ void p0_transpose_item(const float* W, int K, int N, u16* WT, int mode, LAS float* scr, int item, int lane) {
    const int nblk = N / 32, kb = item / nblk, nb = item % nblk, k0 = 64 * kb, n0 = 32 * nb;
    int d0 = n0;
    if (mode == 1) { if (n0 < DFF) d0 = (n0 >> 7) * 256 + (n0 & 127); else { const int n1 = n0 - DFF; d0 = (n1 >> 7) * 256 + 128 + (n1 & 127); } }
    else if (mode == 2) { if (n0 < 1024) d0 = 2048 + n0; else if (n0 < 2048) { const int n1 = n0 - 1024; d0 = (n1 >> 7) * 256 + (n1 & 127); } else { const int n1 = n0 - 2048; d0 = (n1 >> 7) * 256 + 128 + (n1 & 127); } }
#pragma unroll 8
    for (int i = 0; i < 32; ++i) { const int kk = 2 * i + (lane >> 5); scr[kk * 33 + (lane & 31)] = W[(size_t)(k0 + kk) * N + n0 + (lane & 31)]; }
    asm volatile("s_waitcnt lgkmcnt(0)" ::: "memory");
    const int c = lane & 7;
#pragma unroll
    for (int j = 0; j < 4; ++j) { const int n = (lane >> 3) + 8 * j; const LAS float* s = scr + (8 * c) * 33 + n;
        u32x4 o; o.x = pk2(s[0 * 33], s[1 * 33]); o.y = pk2(s[2 * 33], s[3 * 33]); o.z = pk2(s[4 * 33], s[5 * 33]); o.w = pk2(s[6 * 33], s[7 * 33]);
        *(u32x4*)(WT + (size_t)(d0 + n) * K + k0 + 8 * c) = o; }
    asm volatile("s_waitcnt lgkmcnt(0)" ::: "memory");
}

__device__ __forceinline__ void premod_rows(const float* xA, const float* xB, const float* nw, const float* scale, u16* H, float* rowss, int gw, int ngw, int lane) {
    for (int row = gw; row < NTOK; row += ngw) {
        const float* xr = (row < NCTX ? xA + (size_t)row * DM : xB + (size_t)(row - NCTX) * DM);
        const float* sg = scale + row_group(row) * NMODC;
        f32x4 v[4]; float ss = 0.f;
#pragma unroll
        for (int j = 0; j < 4; ++j) { v[j] = *(const f32x4*)(xr + 4 * lane + 256 * j); ss += (v[j][0] * v[j][0] + v[j][1] * v[j][1]) + (v[j][2] * v[j][2] + v[j][3] * v[j][3]); }
        ss = wave_sum(ss);
        if (lane < 4) rowss[(size_t)lane * NTOK + row] = lane == 0 ? ss : 0.f;
#pragma unroll
        for (int j = 0; j < 4; ++j) { const int c = 4 * lane + 256 * j;
            const f32x4 w = *(const f32x4*)(nw + c), sc = *(const f32x4*)(sg + c);
            const f32x4 o = v[j] * w * (sc + 1.0f);
            u32x2 p; p.x = pk2(o[0], o[1]); p.y = pk2(o[2], o[3]);
            *(u32x2*)(H + (size_t)row * DM + c) = p; }
    }
}

__device__ __forceinline__ void bias_row(const u16* Wt, int n, const float* shift, float* bias, int lane) {
    const u16* wr = Wt + (size_t)n * DM;
    const u32x4 w0 = *(const u32x4*)(wr + 8 * lane), w1 = *(const u32x4*)(wr + 512 + 8 * lane);
    float wv[16];
#pragma unroll
    for (int q = 0; q < 4; ++q) { wv[2 * q] = bflo(w0[q]); wv[2 * q + 1] = bfhi(w0[q]); wv[8 + 2 * q] = bflo(w1[q]); wv[8 + 2 * q + 1] = bfhi(w1[q]); }
#pragma unroll
    for (int g = 0; g < 3; ++g) {
        const float* sp = shift + g * NMODC;
        float s = 0.f;
#pragma unroll
        for (int q = 0; q < 2; ++q) { const f32x4 a = *(const f32x4*)(sp + 8 * lane + 4 * q), b = *(const f32x4*)(sp + 512 + 8 * lane + 4 * q);
#pragma unroll
            for (int i = 0; i < 4; ++i) s += wv[4 * q + i] * a[i] + wv[8 + 4 * q + i] * b[i]; }
        s = wave_sum(s);
        if (lane == 0) bias[g * 5632 + n] = s;
    }
}

__device__ __forceinline__ void final_norm_rows(const u16* X16, float* Y, const float* nw, const float* rowss, int gw, int ngw, int lane) {
    for (int row = gw; row < NTOK; row += ngw) {
        const u16* xr = X16 + (size_t)row * DM; float* yr = Y + (size_t)row * DM;
        const float rstd = rstd4(rowss + row);
#pragma unroll
        for (int j = 0; j < 4; ++j) { const int c = 4 * lane + 256 * j; const f32x4 w = *(const f32x4*)(nw + c); const u32x2 h = *(const u32x2*)(xr + c);
            const f32x4 v = {hlo(h.x), hhi(h.x), hlo(h.y), hhi(h.y)}; *(f32x4*)(yr + c) = (v * rstd) * w; }
    }
}

__device__ __forceinline__ void mods_item(int mi, const float* c_ctx, const float* c, const float* ada_w, const float* ada_b, float* mods, LAS float* red, int tid) {
    const int wave = tid >> 6, lane = tid & 63;
    const int l = mi / 96, rem = mi % 96, cc = rem >> 2, kqr = rem & 3;
    const float* W = ada_w + (size_t)l * DM * NMODC + 256 * cc + 4 * lane;
    const int kbase = 256 * kqr + 32 * wave;
    f32x4 a0 = {0.f, 0.f, 0.f, 0.f}, a1 = a0, a2 = a0;
#pragma unroll 8
    for (int kk = 0; kk < 32; ++kk) {
        const int k = kbase + kk;
        const f32x4 w = *(const f32x4*)(W + (size_t)k * NMODC);
        const float s0 = siluf(c_ctx[k]), s1 = siluf(c[k]), s2 = siluf(c[DM + k]);
        a0 += w * s0; a1 += w * s1; a2 += w * s2;
    }
    *(LAS f32x4*)(red + (wave * 3 + 0) * 256 + 4 * lane) = a0;
    *(LAS f32x4*)(red + (wave * 3 + 1) * 256 + 4 * lane) = a1;
    *(LAS f32x4*)(red + (wave * 3 + 2) * 256 + 4 * lane) = a2;
    __syncthreads();
    for (int e = tid; e < 768; e += 512) {
        const int g = e >> 8, col = e & 255; float s = 0.f;
#pragma unroll
        for (int w = 0; w < 8; ++w) s += red[(w * 3 + g) * 256 + col];
        if (kqr == 0) s += ada_b[l * NMODC + 256 * cc + col];
        unsafeAtomicAdd(mods + (size_t)(l * 3 + g) * NMODC + 256 * cc + col, s);
    }
    __syncthreads();
}

constexpr int GL_QD = 0, GL_KI = 8704, GL_KST = 17408, GL_VT = 26624, GL_DV = 35840, GL_BUF = 36352, GL_RED = 72704, GL_STASH = 73728, GL_SROW = 256;
static_assert(GL_STASH + 256 * GL_SROW <= MISC_OFF, "scan LDS map");
__device__ __forceinline__ bf16x8 gl_frag(const LAS unsigned char* p) {
    const u32x2 a = *(const LAS u32x2*)p, b = *(const LAS u32x2*)(p + 32);
    u32x4 r; r.x = a.x; r.y = a.y; r.z = b.x; r.w = b.y; return __builtin_bit_cast(bf16x8, r);
}
__device__ __forceinline__ bf16x8 gl_pack(const f32x4& a, const f32x4& b) { u32x4 r; r.x = pk2(a[0], a[1]); r.y = pk2(a[2], a[3]); r.z = pk2(b[0], b[1]); r.w = pk2(b[2], b[3]); return __builtin_bit_cast(bf16x8, r); }

template <int MODE, int DIR>
__device__ __forceinline__ void gla_pass(LAS unsigned char* L, const u16* Qp, const u16* Lp, const u16* Vp, u16* stash, const u16* Gp, u16* outp,
                                         int row0, int h, const float* Sinit, float* Sout, float* Dout, const float* gnw, int tid_in) {
    int tid = tid_in; asm volatile("" : "+v"(tid));
    const int wave = __builtin_amdgcn_readfirstlane(tid >> 6), lane = tid & 63, fr = lane & 15, kq = lane >> 4;
    const int hoff = h * 128; constexpr int dir = DIR;
    const int tg = lane >> 3, dp = 8 * wave + (lane & 7);
    f32x4 S[8];
#pragma unroll
    for (int t = 0; t < 8; ++t)
#pragma unroll
        for (int i = 0; i < 4; ++i) S[t][i] = Sinit ? Sinit[(16 * t + 4 * kq + i) * 128 + 16 * wave + fr] : 0.f;
    float gs0 = 0.f, gs1 = 0.f;
    unsigned rqA[4], rlA[4], rvA[4], rqB[4], rlB[4], rvB[4]; u16 rgA[2][4], rgB[2][4];
#define GLA_LOAD(ci) do { _Pragma("unroll") for (int j = 0; j < 4; ++j) { const int tau = 32 * (ci) + 4 * tg + j; const size_t ro = (size_t)(row0 + (dir ? 255 - tau : tau)) * DM + hoff + 2 * dp; \
        if (MODE != 0) rq[j] = *(const unsigned*)(Qp + ro); rl[j] = *(const unsigned*)(Lp + ro); rv[j] = *(const unsigned*)(Vp + ro); } \
        if (MODE == 2) { _Pragma("unroll") for (int ct = 0; ct < 2; ++ct) _Pragma("unroll") for (int i = 0; i < 4; ++i) { const int tau = 32 * (ci) + 16 * ct + 4 * kq + i; \
            const size_t ro = (size_t)(row0 + (dir ? 255 - tau : tau)) * DM + hoff + 16 * wave + fr; rg_[ct][i] = Gp[ro]; } } } while (0)
    { unsigned (&rq)[4] = rqA, (&rl)[4] = rlA, (&rv)[4] = rvA; u16 (&rg_)[2][4] = rgA; GLA_LOAD(0); }
    { unsigned (&rq)[4] = rqB, (&rl)[4] = rlB, (&rv)[4] = rvB; u16 (&rg_)[2][4] = rgB; GLA_LOAD(1); }
    auto step = [&](const int ci, unsigned (&rq)[4], unsigned (&rl)[4], unsigned (&rv)[4], u16 (&rg_)[2][4], LAS unsigned char* B) __attribute__((always_inline)) {
        float q0[4], q1[4], c0[4], c1[4], k0[4], k1[4]; unsigned vc[4];
#pragma unroll
        for (int j = 0; j < 4; ++j) { if (MODE != 0) { q0[j] = bflo(rq[j]); q1[j] = bfhi(rq[j]); } else { q0[j] = 0.f; q1[j] = 0.f; }
            const float l0 = hlo(rl[j]), l1 = hhi(rl[j]); k0[j] = 1.f - __expf(l0); k1[j] = 1.f - __expf(l1);
            c0[j] = l0 + (j ? c0[j ? j - 1 : 0] : 0.f); c1[j] = l1 + (j ? c1[j ? j - 1 : 0] : 0.f); vc[j] = rv[j]; }
        float gg_[2][4];
        if (MODE == 2) {
#pragma unroll
            for (int ct = 0; ct < 2; ++ct)
#pragma unroll
                for (int i = 0; i < 4; ++i) gg_[ct][i] = bf1(rg_[ct][i]);
        }
        { const int cn = ci + 2 < 8 ? ci + 2 : 7; GLA_LOAD(cn); }
        float in0 = c0[3], in1 = c1[3];
        { float t0 = __shfl_up(in0, 8), t1 = __shfl_up(in1, 8); if (tg >= 1) { in0 += t0; in1 += t1; }
          t0 = __shfl_up(in0, 16); t1 = __shfl_up(in1, 16); if (tg >= 2) { in0 += t0; in1 += t1; }
          t0 = __shfl_up(in0, 32); t1 = __shfl_up(in1, 32); if (tg >= 4) { in0 += t0; in1 += t1; } }
        const float pre0 = in0 - c0[3], pre1 = in1 - c1[3];
        const float gl0 = __shfl(in0, 56 + (lane & 7)), gl1 = __shfl(in1, 56 + (lane & 7));
        float ks0[4], ks1[4]; const float egl0 = __expf(gl0), egl1 = __expf(gl1);
#pragma unroll
        for (int j = 0; j < 4; ++j) {
            const float g0 = pre0 + c0[j], g1 = pre1 + c1[j];
            const float ki0 = k0[j] * __expf(-g0), ki1 = k1[j] * __expf(-g1);
            ks0[j] = ki0 * egl0; ks1[j] = ki1 * egl1;
            if (MODE != 0) {
                const int s = 4 * tg + j;
                *(LAS unsigned*)(B + GL_QD + s * 272 + 4 * dp) = pk2(q0[j] * __expf(g0), q1[j] * __expf(g1));
                *(LAS unsigned*)(B + GL_KI + s * 272 + 4 * dp) = pk2(ki0, ki1);
            }
        }
        { u32x2 a, b; a.x = pk2(ks0[0], ks0[1]); a.y = pk2(ks0[2], ks0[3]); b.x = pk2(ks1[0], ks1[1]); b.y = pk2(ks1[2], ks1[3]);
          *(LAS u32x2*)(B + GL_KST + (2 * dp) * 72 + 8 * tg) = a; *(LAS u32x2*)(B + GL_KST + (2 * dp + 1) * 72 + 8 * tg) = b;
          u32x2 c, d; c.x = (vc[0] & 0xffffu) | (vc[1] << 16); c.y = (vc[2] & 0xffffu) | (vc[3] << 16); d.x = (vc[0] >> 16) | (vc[1] & 0xffff0000u); d.y = (vc[2] >> 16) | (vc[3] & 0xffff0000u);
          *(LAS u32x2*)(B + GL_VT + (2 * dp) * 72 + 8 * tg) = c; *(LAS u32x2*)(B + GL_VT + (2 * dp + 1) * 72 + 8 * tg) = d; }
        if (tg == 0) { *(LAS f32x2*)(B + GL_DV + 8 * dp) = (f32x2){egl0, egl1}; gs0 += gl0; gs1 += gl1; }
        LBAR();
        const bf16x8 vb = gl_frag(B + GL_VT + (16 * wave + fr) * 72 + 8 * kq);
        f32x4 o[2] = {{0.f, 0.f, 0.f, 0.f}, {0.f, 0.f, 0.f, 0.f}};
        if (MODE != 0) {
            bf16x8 qf[2][4];
#pragma unroll
            for (int ct = 0; ct < 2; ++ct)
#pragma unroll
                for (int p = 0; p < 4; ++p) qf[ct][p] = gl_frag(B + GL_QD + (16 * ct + fr) * 272 + (32 * p + 4 * kq) * 2);
#pragma unroll
            for (int p = 0; p < 4; ++p) { const bf16x8 sb = gl_pack(S[2 * p], S[2 * p + 1]);
                o[0] = __builtin_amdgcn_mfma_f32_16x16x32_bf16(qf[0][p], sb, o[0], 0, 0, 0); o[1] = __builtin_amdgcn_mfma_f32_16x16x32_bf16(qf[1][p], sb, o[1], 0, 0, 0); }
            f32x4 s00 = {0.f, 0.f, 0.f, 0.f}, s01 = s00, s11 = s00;
#pragma unroll
            for (int p = 0; p < 4; ++p) {
                const bf16x8 kf0 = gl_frag(B + GL_KI + fr * 272 + (32 * p + 4 * kq) * 2), kf1 = gl_frag(B + GL_KI + (16 + fr) * 272 + (32 * p + 4 * kq) * 2);
                s00 = __builtin_amdgcn_mfma_f32_16x16x32_bf16(kf0, qf[0][p], s00, 0, 0, 0);
                s01 = __builtin_amdgcn_mfma_f32_16x16x32_bf16(kf0, qf[1][p], s01, 0, 0, 0);
                s11 = __builtin_amdgcn_mfma_f32_16x16x32_bf16(kf1, qf[1][p], s11, 0, 0, 0);
            }
#pragma unroll
            for (int i = 0; i < 4; ++i) if (4 * kq + i > fr) { s00[i] = 0.f; s11[i] = 0.f; }
            const f32x4 z4 = {0.f, 0.f, 0.f, 0.f};
            const bf16x8 pa0 = gl_pack(s00, z4), pa1 = gl_pack(s01, s11);
            o[0] = __builtin_amdgcn_mfma_f32_16x16x32_bf16(pa0, vb, o[0], 0, 0, 0); o[1] = __builtin_amdgcn_mfma_f32_16x16x32_bf16(pa1, vb, o[1], 0, 0, 0);
        }
#pragma unroll
        for (int t = 0; t < 8; ++t) {
            const f32x4 dv = *(const LAS f32x4*)(B + GL_DV + (16 * t + 4 * kq) * 4);
            const bf16x8 ka = gl_frag(B + GL_KST + (16 * t + fr) * 72 + 8 * kq);
            S[t] = S[t] * dv;
            S[t] = __builtin_amdgcn_mfma_f32_16x16x32_bf16(ka, vb, S[t], 0, 0, 0);
        }
        if (MODE == 1) {
#pragma unroll
            for (int ct = 0; ct < 2; ++ct)
#pragma unroll
                for (int i = 0; i < 4; ++i) { const int tau = 32 * ci + 16 * ct + 4 * kq + i, tok = dir ? 255 - tau : tau;
                    *(LAS u16*)(L + GL_STASH + tok * GL_SROW + (16 * wave + fr) * 2) = (u16)(pk2(o[ct][i], 0.f) & 0xffffu); }
        }
        if (MODE == 2) {
            float ov[2][4], ssv[2][4];
#pragma unroll
            for (int ct = 0; ct < 2; ++ct)
#pragma unroll
                for (int i = 0; i < 4; ++i) { const int tau = 32 * ci + 16 * ct + 4 * kq + i, tok = dir ? 255 - tau : tau;
                    ov[ct][i] = o[ct][i] + bf1(*(const LAS u16*)(L + GL_STASH + tok * GL_SROW + (16 * wave + fr) * 2));
                    ssv[ct][i] = row16_sum(ov[ct][i] * ov[ct][i]); }
            if (fr == 0) {
#pragma unroll
                for (int ct = 0; ct < 2; ++ct) *(LAS f32x4*)(L + GL_RED + (wave * 32 + 16 * ct + 4 * kq) * 4) = (f32x4){ssv[ct][0], ssv[ct][1], ssv[ct][2], ssv[ct][3]};
            }
            const float gw_ = gnw[16 * wave + fr];
            LBAR();
#pragma unroll
            for (int ct = 0; ct < 2; ++ct) {
                f32x4 tot = {0.f, 0.f, 0.f, 0.f};
#pragma unroll
                for (int w = 0; w < 8; ++w) tot += *(const LAS f32x4*)(L + GL_RED + (w * 32 + 16 * ct + 4 * kq) * 4);
#pragma unroll
                for (int i = 0; i < 4; ++i) { const int tau = 32 * ci + 16 * ct + 4 * kq + i, tok = dir ? 255 - tau : tau;
                    const float rstd = frsq(tot[i] * (1.f / 128.f) + EPSN);
                    *(LAS u16*)(L + GL_STASH + tok * GL_SROW + (16 * wave + fr) * 2) = (u16)(pk2(ov[ct][i] * rstd * gw_ * gg_[ct][i], 0.f) & 0xffffu); }
            }
        }
    };
#pragma unroll 1
    for (int c2 = 0; c2 < 8; c2 += 2) { step(c2, rqA, rlA, rvA, rgA, L); step(c2 + 1, rqB, rlB, rvB, rgB, L + GL_BUF); }
#undef GLA_LOAD
    if (MODE == 2 && outp != nullptr) {
        LBAR();
#pragma unroll
        for (int k = 0; k < 8; ++k) { const int pc = tid + 512 * k, row = pc >> 4, c16 = pc & 15;
            const u32x4 v = *(const LAS u32x4*)(L + GL_STASH + row * GL_SROW + c16 * 16);
            *(u32x4*)(outp + (size_t)(row0 + row) * DM + hoff + c16 * 8) = v; }
    }
    if (Sout) {
#pragma unroll
        for (int t = 0; t < 8; ++t)
#pragma unroll
            for (int i = 0; i < 4; ++i) Sout[(16 * t + 4 * kq + i) * 128 + 16 * wave + fr] = S[t][i];
    }
    if (MODE == 0 && tg == 0) { Dout[2 * dp] = __expf(gs0); Dout[2 * dp + 1] = __expf(gs1); }
    asm volatile("s_waitcnt vmcnt(0)" ::: "memory");
    __syncthreads();
}

__device__ __forceinline__ void sconv_rows(const u16* cu, const u16* gb, const float* cw, const float* cb, u16* A2, int gtid, int ngt) {
    for (int it = gtid; it < NTOK * 128; it += ngt) {
        const int row = it >> 7, c = (it & 127) * 8;
        bool hp, hn; int dlt;
        if (row < NCTX) { dlt = 1; const int t = row & 255; hp = t > 0; hn = t < 255; }
        else { dlt = 64; const int t = (row - NCTX) & 4095; hp = t >= 64; hn = t < 4096 - 64; }
        const u32x4 z = {0u, 0u, 0u, 0u};
        const u32x4 m = *(const u32x4*)(cu + (size_t)row * DM + c);
        const u32x4 p = hp ? *(const u32x4*)(cu + (size_t)(row - dlt) * DM + c) : z;
        const u32x4 n = hn ? *(const u32x4*)(cu + (size_t)(row + dlt) * DM + c) : z;
        const u32x4 g = *(const u32x4*)(gb + (size_t)row * DM + c);
        float w0[8], w1[8], w2[8], bb[8];
#pragma unroll
        for (int q = 0; q < 2; ++q) { const f32x4 a = *(const f32x4*)(cw + c + 4 * q), b = *(const f32x4*)(cw + DM + c + 4 * q), d = *(const f32x4*)(cw + 2 * DM + c + 4 * q), e = *(const f32x4*)(cb + c + 4 * q);
#pragma unroll
            for (int i = 0; i < 4; ++i) { w0[4 * q + i] = a[i]; w1[4 * q + i] = b[i]; w2[4 * q + i] = d[i]; bb[4 * q + i] = e[i]; } }
        u32x4 o;
#pragma unroll
        for (int q = 0; q < 4; ++q) {
            const float zl = w0[2 * q] * bflo(p[q]) + w1[2 * q] * bflo(m[q]) + w2[2 * q] * bflo(n[q]) + bb[2 * q];
            const float zh = w0[2 * q + 1] * bfhi(p[q]) + w1[2 * q + 1] * bfhi(m[q]) + w2[2 * q + 1] * bfhi(n[q]) + bb[2 * q + 1];
            o[q] = pk2(zl * bflo(g[q]), zh * bfhi(g[q]));
        }
        *(u32x4*)(A2 + (size_t)row * DM + c) = o;
    }
}

#ifndef PROBE
#define PROBE 0
#endif
#ifndef PH
#define PH 0x7fff
#endif
struct Args { const float* in[22]; float* out; unsigned char* ws; };
enum { I_XP = 0, I_XS, I_STATE, I_C, I_CCTX, I_ADAW, I_ADAB, I_NMIX, I_NFFN, I_HWIN, I_HLB, I_HGN, I_HWOUT, I_SWIN, I_SCW, I_SCB, I_SWOUT, I_FUP, I_FCW, I_FCB, I_FDN, I_FNW };

#define KAS __attribute__((address_space(4)))
#define GRID_BAR() do { const KAS Args* bp_ = (const KAS Args*)__builtin_amdgcn_kernarg_segment_ptr(); asm volatile("" : "+s"(bp_)); \
    XcdBarrier b_; b_.bar = (unsigned*)(bp_->ws + WS_CTL) + CW_BAR; b_.x = xb_xcc_id(); b_.st = (volatile LAS unsigned*)((LAS unsigned char*)lds + MISC_OFF) + 8; xcd_barrier(b_); } while (0)
#define PHASE_ENV() const KAS Args* ap_ = (const KAS Args*)__builtin_amdgcn_kernarg_segment_ptr(); asm volatile("" : "+s"(ap_)); \
    unsigned char* ws = ap_->ws; float* out = ap_->out; (void)ws; (void)out; \
    int tid_ = threadIdx.x; asm volatile("" : "+v"(tid_)); const int tid = tid_, lane = tid & 63, wave = __builtin_amdgcn_readfirstlane(tid >> 6); \
    const int G = gridDim.x, blk = blockIdx.x, gw = blk * NWAVES + wave, NGW = G * NWAVES; (void)lane; (void)gw; (void)NGW; \
    float* mods = (float*)(ws + WS_MODS); (void)mods; u16* X16 = (u16*)(ws + WS_BIG) + 4 * PL; (void)X16
#define IN(k) (ap_->in[k])

__global__ void __launch_bounds__(NWAVES * 64, 2) hgrn_dit_fwd(Args args) {
    extern __shared__ __attribute__((aligned(16))) unsigned char lds[];
    LAS unsigned char* L = (LAS unsigned char*)lds;
    volatile LAS unsigned* MISC = (volatile LAS unsigned*)(L + MISC_OFF);
    for (int u = threadIdx.x; u < 32; u += NWAVES * 64) MISC[u] = 0u;
    __syncthreads();
    (void)xcd_barrier_post((unsigned*)(args.ws + WS_CTL) + CW_BAR, MISC + 8);

    {
        PHASE_ENV();
        if (PH & 1) if (blk < 192) mods_item(blk, IN(I_CCTX), IN(I_C), IN(I_ADAW), IN(I_ADAB), mods, (LAS float*)L, tid);
        if (blk == G - 1) {
            const float* lbnd = IN(I_HLB);
            float* lbv = (float*)(ws + WS_LB);
            for (int e = tid; e < 2048; e += NWAVES * 64) { const int dir = e >> 10, i = e & 1023; lbv[e] = frcp(1.f + __expf(lbnd[dir * 2048 + 1024 + i] - lbnd[dir * 2048 + i])); }
        }
        LAS float* scr = (LAS float*)(L + wave * 16384);
        constexpr int I_A = (DM / 64) * (5120 / 32), I_B = (DM / 64) * (DM / 32), I_C2 = (DM / 64) * (3072 / 32), I_U = (DM / 64) * (2 * DFF / 32), I_D = (DFF / 64) * (DM / 32);
        constexpr int NITEMS = I_A + I_B + I_C2 + I_B + 2 * I_U + 2 * I_D;
        if (PH & 2) for (int it = gw; it < NITEMS; it += NGW) {
            int r = it;
            if (r < I_A) { p0_transpose_item(IN(I_HWIN), DM, 5120, (u16*)(ws + WS_W_HIN), 0, scr, r, lane); continue; } r -= I_A;
            if (r < I_B) { p0_transpose_item(IN(I_HWOUT), DM, DM, (u16*)(ws + WS_W_HOUT), 0, scr, r, lane); continue; } r -= I_B;
            if (r < I_C2) { p0_transpose_item(IN(I_SWIN), DM, 3072, (u16*)(ws + WS_W_SIN), 2, scr, r, lane); continue; } r -= I_C2;
            if (r < I_B) { p0_transpose_item(IN(I_SWOUT), DM, DM, (u16*)(ws + WS_W_SOUT), 0, scr, r, lane); continue; } r -= I_B;
            if (r < I_U) { p0_transpose_item(IN(I_FUP), DM, 2 * DFF, (u16*)(ws + WS_W_UP0), 1, scr, r, lane); continue; } r -= I_U;
            if (r < I_U) { p0_transpose_item(IN(I_FUP) + (size_t)DM * 2 * DFF, DM, 2 * DFF, (u16*)(ws + WS_W_UP1), 1, scr, r, lane); continue; } r -= I_U;
            if (r < I_D) { p0_transpose_item(IN(I_FDN), DFF, DM, (u16*)(ws + WS_W_DN0), 0, scr, r, lane); continue; } r -= I_D;
            p0_transpose_item(IN(I_FDN) + (size_t)DFF * DM, DFF, DM, (u16*)(ws + WS_W_DN1), 0, scr, r, lane);
        }
    }
    GRID_BAR();

    if (PH & 4) { PHASE_ENV(); float* rowss = (float*)(ws + WS_ROWSS); float* bias = (float*)(ws + WS_BIAS);
        premod_rows(IN(I_XP), IN(I_XS), IN(I_NMIX), mods + 1 * 1024, (u16*)(ws + WS_H), rowss, gw, NGW, lane);
        for (int r = gw; r < 5120 + 5632 + 3072 + 5632; r += NGW) {
            if (r < 5120) bias_row((const u16*)(ws + WS_W_HIN), r, mods + 0 * 1024, bias, lane);
            else if (r < 5120 + 5632) bias_row((const u16*)(ws + WS_W_UP0), r - 5120, mods + 3 * 1024, bias + BIAS_STRIDE, lane);
            else if (r < 5120 + 5632 + 3072) bias_row((const u16*)(ws + WS_W_SIN), r - 5120 - 5632, mods + 3 * NMODC + 0 * 1024, bias + 2 * BIAS_STRIDE, lane);
            else bias_row((const u16*)(ws + WS_W_UP1), r - 5120 - 5632 - 3072, mods + 3 * NMODC + 3 * 1024, bias + 3 * BIAS_STRIDE, lane);
        }
    }
    GRID_BAR();

#if PROBE == 3
    { PHASE_ENV();
        LAS float* scr = (LAS float*)(L + wave * 16384);
        constexpr int I_A = (DM / 64) * (5120 / 32), I_B = (DM / 64) * (DM / 32), I_C2 = (DM / 64) * (3072 / 32), I_U = (DM / 64) * (2 * DFF / 32), I_D = (DFF / 64) * (DM / 32);
        constexpr int NITEMS = I_A + I_B + I_C2 + I_B + 2 * I_U + 2 * I_D;
        if (PH & 2) for (int it = gw; it < NITEMS; it += NGW) {
            int r = it;
            if (r < I_A) { p0_transpose_item(IN(I_HWIN), DM, 5120, (u16*)(ws + WS_W_HIN), 0, scr, r, lane); continue; } r -= I_A;
            if (r < I_B) { p0_transpose_item(IN(I_HWOUT), DM, DM, (u16*)(ws + WS_W_HOUT), 0, scr, r, lane); continue; } r -= I_B;
            if (r < I_C2) { p0_transpose_item(IN(I_SWIN), DM, 3072, (u16*)(ws + WS_W_SIN), 2, scr, r, lane); continue; } r -= I_C2;
            if (r < I_B) { p0_transpose_item(IN(I_SWOUT), DM, DM, (u16*)(ws + WS_W_SOUT), 0, scr, r, lane); continue; } r -= I_B;
            if (r < I_U) { p0_transpose_item(IN(I_FUP), DM, 2 * DFF, (u16*)(ws + WS_W_UP0), 1, scr, r, lane); continue; } r -= I_U;
            if (r < I_U) { p0_transpose_item(IN(I_FUP) + (size_t)DM * 2 * DFF, DM, 2 * DFF, (u16*)(ws + WS_W_UP1), 1, scr, r, lane); continue; } r -= I_U;
            if (r < I_D) { p0_transpose_item(IN(I_FDN), DFF, DM, (u16*)(ws + WS_W_DN0), 0, scr, r, lane); continue; } r -= I_D;
            p0_transpose_item(IN(I_FDN) + (size_t)DFF * DM, DFF, DM, (u16*)(ws + WS_W_DN1), 0, scr, r, lane);
        }
    }
    GRID_BAR();
    if (PH & 4) { PHASE_ENV(); float* rowss = (float*)(ws + WS_ROWSS); float* bias = (float*)(ws + WS_BIAS);
        premod_rows(IN(I_XP), IN(I_XS), IN(I_NMIX), mods + 1 * 1024, (u16*)(ws + WS_H), rowss, gw, NGW, lane);
        for (int r = gw; r < 5120 + 5632 + 3072 + 5632; r += NGW) {
            if (r < 5120) bias_row((const u16*)(ws + WS_W_HIN), r, mods + 0 * 1024, bias, lane);
            else if (r < 5120 + 5632) bias_row((const u16*)(ws + WS_W_UP0), r - 5120, mods + 3 * 1024, bias + BIAS_STRIDE, lane);
            else if (r < 5120 + 5632 + 3072) bias_row((const u16*)(ws + WS_W_SIN), r - 5120 - 5632, mods + 3 * NMODC + 0 * 1024, bias + 2 * BIAS_STRIDE, lane);
            else bias_row((const u16*)(ws + WS_W_UP1), r - 5120 - 5632 - 3072, mods + 3 * NMODC + 3 * 1024, bias + 3 * BIAS_STRIDE, lane);
        }
    }
    GRID_BAR();

#endif
#pragma unroll
    for (int layer = 0; layer < 2; ++layer) {
        if (layer == 0) {
            for (int rp2_ = 0; rp2_ < (PROBE == 2 ? 2 : 1); ++rp2_) {
            if (PH & 8) { PHASE_ENV(); pg8::Gemm g{(const u16*)(ws + WS_H), (const u16*)(ws + WS_W_HIN), NTOK, 5120, DM}; pg8::StaticOrder S; S.init(NTOK, 5120, G, blk);
              EpiProj E{(u16*)(ws + WS_BIG), (const float*)(ws + WS_LB), (const float*)(ws + WS_ROWSS), (const float*)(ws + WS_BIAS), (LAS float*)(L + XCH_OFF)};
              pg8::gemm_phase<EpiProj, pg8::StaticOrder, true, true>(L, g, S, E); }
            GRID_BAR();
            }
            for (int rp6_ = (PROBE == 6 ? 0 : 1); rp6_ < 2; ++rp6_) {
            for (int rp4_ = 0; rp4_ < (PROBE == 4 ? 2 : 1); ++rp4_) { if (rp4_) GRID_BAR();
            if (PH & 16) for (int idx = blockIdx.x; idx < 512; idx += gridDim.x) {
                PHASE_ENV(); u16* BIG = (u16*)(ws + WS_BIG); float* SEGKV = (float*)(ws + WS_H); float* SEGD = (float*)(ws + WS_SEGD);
                const int b = idx >> 8, h = (idx >> 5) & 7, dir = (idx >> 4) & 1, seg = idx & 15;
                if ((dir == 0 && seg == 15) || (dir == 1 && seg == 0)) continue;
                if (dir == 0) gla_pass<0, 0>(L, nullptr, BIG + 1 * PL, BIG + 3 * PL, nullptr, nullptr, nullptr, NCTX + b * 4096 + seg * 256, h, nullptr, SEGKV + (size_t)idx * 16384, SEGD + (size_t)idx * 128, nullptr, tid);
                else gla_pass<0, 1>(L, nullptr, BIG + 2 * PL, BIG + 3 * PL, nullptr, nullptr, nullptr, NCTX + b * 4096 + seg * 256, h, nullptr, SEGKV + (size_t)idx * 16384, SEGD + (size_t)idx * 128, nullptr, tid);
            }
            }
            GRID_BAR();
            if (PH & 32) for (int w = blockIdx.x; w < 256; w += gridDim.x) {
                PHASE_ENV(); float* SEGKV = (float*)(ws + WS_H); const float* SEGD = (const float*)(ws + WS_SEGD);
                const int chain = w >> 3, part = w & 7, e4 = (part * 512 + tid) * 4, d = e4 >> 7;
                const int dir = chain & 1, bh = chain >> 1;
                const int b = bh >> 3, h = bh & 7;
                f32x4 S = *(const f32x4*)(IN(I_STATE) + ((size_t)((b * 2 + dir) * 8 + h)) * 16384 + e4);
                f32x4 kv[15]; float dd[15];
#pragma unroll
                for (int k = 0; k < 15; ++k) { const int seg = dir ? 15 - k : k; kv[k] = *(const f32x4*)(SEGKV + ((size_t)chain * 16 + seg) * 16384 + e4); dd[k] = SEGD[((size_t)chain * 16 + seg) * 128 + d]; }
#pragma unroll
                for (int k = 0; k < 16; ++k) { const int seg = dir ? 15 - k : k; *(f32x4*)(SEGKV + ((size_t)chain * 16 + seg) * 16384 + e4) = S; if (k < 15) S = S * dd[k < 15 ? k : 0] + kv[k < 15 ? k : 0]; }
            }
            GRID_BAR();
            if (PH & 64) for (int it = blockIdx.x; it < 512; it += gridDim.x) {
                PHASE_ENV(); u16* BIG = (u16*)(ws + WS_BIG); const float* SEGKV = (const float*)(ws + WS_H);
                int row0, h; const float *sif = nullptr, *sib = nullptr; float *sof = nullptr, *sob = nullptr;
                if (it < 256) { const int b = it >> 3; h = it & 7; row0 = b * 256;
                    sof = out + (size_t)NTOK * DM + ((size_t)((b * 2 + 0) * 8 + h)) * 16384; sob = out + (size_t)NTOK * DM + ((size_t)((b * 2 + 1) * 8 + h)) * 16384; }
                else { const int idx = it - 256, b = idx >> 7, seg = idx & 15; h = (idx >> 4) & 7; row0 = NCTX + b * 4096 + seg * 256;
                    sif = SEGKV + ((size_t)(((b * 8 + h) * 2 + 0) * 16 + seg)) * 16384; sib = SEGKV + ((size_t)(((b * 8 + h) * 2 + 1) * 16 + seg)) * 16384; }
                gla_pass<1, 0>(L, BIG, BIG + PL, BIG + 3 * PL, nullptr, nullptr, nullptr, row0, h, sif, sof, nullptr, nullptr, tid);
                gla_pass<2, 1>(L, BIG, BIG + 2 * PL, BIG + 3 * PL, nullptr, BIG + 4 * PL, rp6_ ? BIG : (u16*)nullptr, row0, h, sib, sob, nullptr, IN(I_HGN), tid);
            }
            GRID_BAR();
            }
#if PROBE == 1
            {
    if (PH & 4) { PHASE_ENV(); float* rowss = (float*)(ws + WS_ROWSS); float* bias = (float*)(ws + WS_BIAS);
        premod_rows(IN(I_XP), IN(I_XS), IN(I_NMIX), mods + 1 * 1024, (u16*)(ws + WS_H), rowss, gw, NGW, lane);
        for (int r = gw; r < 5120 + 5632 + 3072 + 5632; r += NGW) {
            if (r < 5120) bias_row((const u16*)(ws + WS_W_HIN), r, mods + 0 * 1024, bias, lane);
            else if (r < 5120 + 5632) bias_row((const u16*)(ws + WS_W_UP0), r - 5120, mods + 3 * 1024, bias + BIAS_STRIDE, lane);
            else if (r < 5120 + 5632 + 3072) bias_row((const u16*)(ws + WS_W_SIN), r - 5120 - 5632, mods + 3 * NMODC + 0 * 1024, bias + 2 * BIAS_STRIDE, lane);
            else bias_row((const u16*)(ws + WS_W_UP1), r - 5120 - 5632 - 3072, mods + 3 * NMODC + 3 * 1024, bias + 3 * BIAS_STRIDE, lane);
        }
    }
    GRID_BAR();

            for (int rp2_ = 0; rp2_ < (PROBE == 2 ? 2 : 1); ++rp2_) {
            if (PH & 8) { PHASE_ENV(); pg8::Gemm g{(const u16*)(ws + WS_H), (const u16*)(ws + WS_W_HIN), NTOK, 5120, DM}; pg8::StaticOrder S; S.init(NTOK, 5120, G, blk);
              EpiProj E{(u16*)(ws + WS_BIG), (const float*)(ws + WS_LB), (const float*)(ws + WS_ROWSS), (const float*)(ws + WS_BIAS), (LAS float*)(L + XCH_OFF)};
              pg8::gemm_phase<EpiProj, pg8::StaticOrder, true, true>(L, g, S, E); }
            GRID_BAR();
            }
            for (int rp6_ = (PROBE == 6 ? 0 : 1); rp6_ < 2; ++rp6_) {
            for (int rp4_ = 0; rp4_ < (PROBE == 4 ? 2 : 1); ++rp4_) { if (rp4_) GRID_BAR();
            if (PH & 16) for (int idx = blockIdx.x; idx < 512; idx += gridDim.x) {
                PHASE_ENV(); u16* BIG = (u16*)(ws + WS_BIG); float* SEGKV = (float*)(ws + WS_H); float* SEGD = (float*)(ws + WS_SEGD);
                const int b = idx >> 8, h = (idx >> 5) & 7, dir = (idx >> 4) & 1, seg = idx & 15;
                if ((dir == 0 && seg == 15) || (dir == 1 && seg == 0)) continue;
                if (dir == 0) gla_pass<0, 0>(L, nullptr, BIG + 1 * PL, BIG + 3 * PL, nullptr, nullptr, nullptr, NCTX + b * 4096 + seg * 256, h, nullptr, SEGKV + (size_t)idx * 16384, SEGD + (size_t)idx * 128, nullptr, tid);
                else gla_pass<0, 1>(L, nullptr, BIG + 2 * PL, BIG + 3 * PL, nullptr, nullptr, nullptr, NCTX + b * 4096 + seg * 256, h, nullptr, SEGKV + (size_t)idx * 16384, SEGD + (size_t)idx * 128, nullptr, tid);
            }
            }
            GRID_BAR();
            if (PH & 32) for (int w = blockIdx.x; w < 256; w += gridDim.x) {
                PHASE_ENV(); float* SEGKV = (float*)(ws + WS_H); const float* SEGD = (const float*)(ws + WS_SEGD);
                const int chain = w >> 3, part = w & 7, e4 = (part * 512 + tid) * 4, d = e4 >> 7;
                const int dir = chain & 1, bh = chain >> 1;
                const int b = bh >> 3, h = bh & 7;
                f32x4 S = *(const f32x4*)(IN(I_STATE) + ((size_t)((b * 2 + dir) * 8 + h)) * 16384 + e4);
                f32x4 kv[15]; float dd[15];
#pragma unroll
                for (int k = 0; k < 15; ++k) { const int seg = dir ? 15 - k : k; kv[k] = *(const f32x4*)(SEGKV + ((size_t)chain * 16 + seg) * 16384 + e4); dd[k] = SEGD[((size_t)chain * 16 + seg) * 128 + d]; }
#pragma unroll
                for (int k = 0; k < 16; ++k) { const int seg = dir ? 15 - k : k; *(f32x4*)(SEGKV + ((size_t)chain * 16 + seg) * 16384 + e4) = S; if (k < 15) S = S * dd[k < 15 ? k : 0] + kv[k < 15 ? k : 0]; }
            }
            GRID_BAR();
            if (PH & 64) for (int it = blockIdx.x; it < 512; it += gridDim.x) {
                PHASE_ENV(); u16* BIG = (u16*)(ws + WS_BIG); const float* SEGKV = (const float*)(ws + WS_H);
                int row0, h; const float *sif = nullptr, *sib = nullptr; float *sof = nullptr, *sob = nullptr;
                if (it < 256) { const int b = it >> 3; h = it & 7; row0 = b * 256;
                    sof = out + (size_t)NTOK * DM + ((size_t)((b * 2 + 0) * 8 + h)) * 16384; sob = out + (size_t)NTOK * DM + ((size_t)((b * 2 + 1) * 8 + h)) * 16384; }
                else { const int idx = it - 256, b = idx >> 7, seg = idx & 15; h = (idx >> 4) & 7; row0 = NCTX + b * 4096 + seg * 256;
                    sif = SEGKV + ((size_t)(((b * 8 + h) * 2 + 0) * 16 + seg)) * 16384; sib = SEGKV + ((size_t)(((b * 8 + h) * 2 + 1) * 16 + seg)) * 16384; }
                gla_pass<1, 0>(L, BIG, BIG + PL, BIG + 3 * PL, nullptr, nullptr, nullptr, row0, h, sif, sof, nullptr, nullptr, tid);
                gla_pass<2, 1>(L, BIG, BIG + 2 * PL, BIG + 3 * PL, nullptr, BIG + 4 * PL, rp6_ ? BIG : (u16*)nullptr, row0, h, sib, sob, nullptr, IN(I_HGN), tid);
            }
            GRID_BAR();
            }
            }
#endif
            for (int rp7_ = (PROBE == 7 ? 0 : 1); rp7_ < 2; ++rp7_) { if (PROBE == 7 && rp7_) GRID_BAR();
            if (PH & 128) { PHASE_ENV(); pg8::Gemm g{(const u16*)(ws + WS_BIG), (const u16*)(ws + WS_W_HOUT), NTOK, DM, DM}; pg8::StaticOrder S; S.init(NTOK, DM, G, blk);
              EpiRes<1, false> E{IN(I_XP), IN(I_XS), X16, mods + 2 * 1024, (u16*)(ws + WS_H), IN(I_NFFN), mods + 4 * 1024, (float*)(ws + WS_ROWSS) + 1 * RSS_STRIDE, (LAS float*)(L + XCH_OFF)};
              pg8::gemm_phase<EpiRes<1, false>, pg8::StaticOrder, true, true>(L, g, S, E); }
            }
        } else {
            if (PH & 256) { PHASE_ENV(); u16* BIG = (u16*)(ws + WS_BIG); pg8::Gemm g{(const u16*)(ws + WS_H), (const u16*)(ws + WS_W_SIN), NTOK, 3072, DM}; pg8::StaticOrder S; S.init(NTOK, 3072, G, blk);
              EpiSconvIn E{BIG, BIG + PL, (const float*)(ws + WS_ROWSS) + 2 * RSS_STRIDE, (const float*)(ws + WS_BIAS) + 2 * BIAS_STRIDE, (LAS float*)(L + XCH_OFF)};
              pg8::gemm_phase<EpiSconvIn, pg8::StaticOrder, true, true>(L, g, S, E); }
            GRID_BAR();
            if (PH & 512) { PHASE_ENV(); u16* BIG = (u16*)(ws + WS_BIG); sconv_rows(BIG, BIG + PL, IN(I_SCW), IN(I_SCB), BIG + 2 * PL, blk * NWAVES * 64 + tid, G * NWAVES * 64); }
            GRID_BAR();
            if (PH & 1024) { PHASE_ENV(); pg8::Gemm g{(const u16*)(ws + WS_BIG) + 2 * PL, (const u16*)(ws + WS_W_SOUT), NTOK, DM, DM}; pg8::StaticOrder S; S.init(NTOK, DM, G, blk);
              EpiRes<1, true> E{nullptr, nullptr, X16, mods + 3 * NMODC + 2 * 1024, (u16*)(ws + WS_H), IN(I_NFFN) + DM, mods + 3 * NMODC + 4 * 1024, (float*)(ws + WS_ROWSS) + 3 * RSS_STRIDE, (LAS float*)(L + XCH_OFF)};
              pg8::gemm_phase<EpiRes<1, true>, pg8::StaticOrder, true, true>(L, g, S, E); }
        }
        GRID_BAR();
        for (int rp5_ = 0; rp5_ < ((PROBE == 5 && layer == 0) ? 2 : 1); ++rp5_) { if (rp5_) GRID_BAR();
        if (PH & 4096) { PHASE_ENV(); pg8::Gemm g{(const u16*)(ws + WS_H), (const u16*)(ws + (layer ? WS_W_UP1 : WS_W_UP0)), NTOK, 2 * DFF, DM}; pg8::StaticOrder S; S.init(NTOK, 2 * DFF, G, blk);
          EpiFfnUp E{(u16*)(ws + WS_BIG), IN(I_FCW) + (size_t)layer * 3 * DFF, IN(I_FCB) + (size_t)layer * DFF, (LAS float*)(L + XCH_OFF), (const float*)(ws + WS_ROWSS) + (layer ? 3 : 1) * RSS_STRIDE, (const float*)(ws + WS_BIAS) + (layer ? 3 : 1) * BIAS_STRIDE};
          pg8::gemm_phase<EpiFfnUp, pg8::StaticOrder, true, true>(L, g, S, E); }
        }
        GRID_BAR();
        if (PH & 8192) { PHASE_ENV(); pg8::Gemm g{(const u16*)(ws + WS_BIG), (const u16*)(ws + (layer ? WS_W_DN1 : WS_W_DN0)), NTOK, DM, DFF}; pg8::StaticOrder S; S.init(NTOK, DM, G, blk);
          if (layer == 0) { for (int rp9_ = (PROBE == 9 ? 0 : 1); rp9_ < 2; ++rp9_) { if (PROBE == 9 && rp9_) GRID_BAR();
          EpiRes<1, true> E{nullptr, nullptr, X16, rp9_ ? mods + 5 * 1024 : (const float*)(ws + 528 * 1024), (u16*)(ws + WS_H), IN(I_NMIX) + DM, mods + 3 * NMODC + 1 * 1024, (float*)(ws + WS_ROWSS) + 2 * RSS_STRIDE, (LAS float*)(L + XCH_OFF)};
            pg8::gemm_phase<EpiRes<1, true>, pg8::StaticOrder, true, true>(L, g, S, E); } }
          else { EpiRes<2, true> E{nullptr, nullptr, X16, mods + 3 * NMODC + 5 * 1024, nullptr, nullptr, nullptr, (float*)(ws + WS_ROWSS) + 4 * RSS_STRIDE, (LAS float*)(L + XCH_OFF)};
            pg8::gemm_phase<EpiRes<2, true>, pg8::StaticOrder, true, true>(L, g, S, E); } }
        GRID_BAR();
    }
    if (PH & 16384) { PHASE_ENV(); final_norm_rows(X16, out, IN(I_FNW), (const float*)(ws + WS_ROWSS) + 4 * RSS_STRIDE, gw, NGW, lane); }
}

extern "C" void kernel_launch(void* const* d_in, const int* in_sizes, int n_in, void* d_out, int out_size, void* d_ws, size_t ws_size, hipStream_t stream) {
    static int grid = 0;
    if (grid == 0) {
        if (n_in != 22 || ws_size < WS_END) { fprintf(stderr, "kernel_launch: unexpected inputs (n_in %d, ws %zu)\n", n_in, ws_size); grid = -1; return; }
        int dev = 0, cus = 0, per_cu = 0;
        if (hipGetDevice(&dev) != hipSuccess || hipDeviceGetAttribute(&cus, hipDeviceAttributeMultiprocessorCount, dev) != hipSuccess) { grid = -1; return; }
        if (hipFuncSetAttribute((const void*)hgrn_dit_fwd, hipFuncAttributeMaxDynamicSharedMemorySize, LDS_BYTES) != hipSuccess) { fprintf(stderr, "kernel_launch: hipFuncSetAttribute failed\n"); grid = -1; return; }
        if (hipOccupancyMaxActiveBlocksPerMultiprocessor(&per_cu, (const void*)hgrn_dit_fwd, NWAVES * 64, LDS_BYTES) != hipSuccess || per_cu < 1) { fprintf(stderr, "kernel_launch: occupancy query says %d\n", per_cu); (void)hipGetLastError(); grid = -1; return; }
        grid = cus;
    }
    if (grid < 0) return;
    (void)hipMemsetAsync((char*)d_ws + WS_CTL, 0, CTL_ZERO_BYTES, stream);
    Args a{};
    for (int i = 0; i < 22; ++i) a.in[i] = (const float*)d_in[i];
    a.out = (float*)d_out; a.ws = (unsigned char*)d_ws;
    void* kargs[] = {&a};
    hipError_t e = hipLaunchCooperativeKernel((const void*)hgrn_dit_fwd, dim3(grid), dim3(NWAVES * 64), kargs, LDS_BYTES, stream);
    if (e != hipSuccess) fprintf(stderr, "kernel_launch: cooperative launch failed: %s (grid %d)\n", hipGetErrorString(e), grid);
}
```
